# Optimizing an MI355X kernel written in HIP

```python
import jax, jax.numpy as jnp
from jax import lax
import numpy as np

D_MODEL = 1024
BATCH = 2
SEQ = 8192
DEPTH = 4

HD = 64
QBLK = 128
A_GROUPS = 3
A_HEADS = 8
A_PATTERNS = ((128, 1), (512, 4), (2048, 16))
A_QKV_W = A_GROUPS * A_HEADS * HD
BRANCH_W = A_HEADS * HD
B_HEADS = 8
B_KV = 2
NSA_CMP_BLK = 32
NSA_CMP_STRIDE = 16
NSA_CMP_HIDDEN = 256
NSA_SEL_BLK = 64
NSA_N_SEL = 16
NSA_WINDOW = 512
C_HEADS = 8
C_KV = 2
C_WINDOW = 128
N_BRANCH = 3
DEEPNORM_ALPHA = (2 * DEPTH) ** 0.25
DEEPNORM_BETA = (8 * DEPTH) ** -0.25
LN_EPS = 1e-5
NEG = -1e30
FORCE_SCORE = 1e4
ATTN_SCALE = HD ** -0.5
IN_WIDTHS = (A_QKV_W, A_QKV_W, A_QKV_W, BRANCH_W,
             B_HEADS * HD, B_KV * HD, B_KV * HD, B_KV * HD, B_KV * HD, B_KV * HD, B_KV * HD,
             BRANCH_W, B_HEADS * 3,
             C_HEADS * HD, C_KV * HD, C_KV * HD, BRANCH_W,
             N_BRANCH * D_MODEL)
IN_COLS = sum(IN_WIDTHS)

kernel_name = "hybrid_dilated_nsa_swa_gated_deepnorm"


def alibi_slopes(n):
    return 2.0 ** (-8.0 * jnp.arange(1, n + 1, dtype=jnp.float32) / n)


def layer_norm(x, g, b):
    xf = x.astype(jnp.float32)
    mu = jnp.mean(xf, axis=-1, keepdims=True)
    var = jnp.mean(jnp.square(xf - mu), axis=-1, keepdims=True)
    return ((xf - mu) * lax.rsqrt(var + LN_EPS) * g.astype(jnp.float32) + b.astype(jnp.float32)).astype(x.dtype)


def banded_attention(q, k, v, slopes, window, dist_scale, sinks=None):
    B, L, H, Dh = q.shape
    Hkv = k.shape[2]
    G = H // Hkv
    nblk = -(-L // QBLK)
    Lp = nblk * QBLK
    nb = -(-window // QBLK)
    pad = Lp - L
    qp = jnp.pad(q, ((0, 0), (0, pad), (0, 0), (0, 0))).reshape(B, nblk, QBLK, Hkv, G, Dh)
    kp = jnp.pad(k, ((0, 0), (nb * QBLK, pad), (0, 0), (0, 0))).reshape(B, nblk + nb, QBLK, Hkv, Dh)
    vp = jnp.pad(v, ((0, 0), (nb * QBLK, pad), (0, 0), (0, 0))).reshape(B, nblk + nb, QBLK, Hkv, Dh)
    kc = jnp.concatenate([kp[:, i:i + nblk] for i in range(nb + 1)], axis=2)
    vc = jnp.concatenate([vp[:, i:i + nblk] for i in range(nb + 1)], axis=2)
    C = (nb + 1) * QBLK
    qi = jnp.arange(QBLK)[:, None]
    ci = jnp.arange(C)[None, :]
    dist = qi - ci + nb * QBLK
    kpos = jnp.arange(nblk)[:, None, None] * QBLK + ci[None] - nb * QBLK
    valid = (dist >= 0)[None] & (dist <= window)[None] & (kpos >= 0)
    s = jnp.einsum('bnikgd,bnckd->bnkgic', qp.astype(jnp.float32), kc.astype(jnp.float32)) * ATTN_SCALE
    s = s - (slopes.reshape(Hkv, G)[:, :, None, None] * dist_scale) * dist.astype(jnp.float32)
    s = jnp.where(valid[None, :, None, None], s, NEG)
    lse = jax.nn.logsumexp(s, axis=-1)
    if sinks is not None:
        lse = jnp.logaddexp(lse, sinks.astype(jnp.float32).reshape(Hkv, G)[:, :, None])
    p = jnp.exp(s - lse[..., None])
    o = jnp.einsum('bnkgic,bnckd->bnikgd', p, vc.astype(jnp.float32))
    o = o.reshape(B, Lp, H, Dh)[:, :L].astype(q.dtype)
    lse = lse.transpose(0, 1, 4, 2, 3).reshape(B, Lp, H)[:, :L]
    return o, lse


def dilated_attention(q, k, v, slopes, window, dilation):
    B, S, H, Dh = q.shape
    r = dilation

    def fold(t):
        return t.reshape(B, S // r, r, t.shape[2], Dh).transpose(0, 2, 1, 3, 4).reshape(B * r, S // r, t.shape[2], Dh)

    o, lse = banded_attention(fold(q), fold(k), fold(v), slopes, window // r, r)
    o = o.reshape(B, r, S // r, H, Dh).transpose(0, 2, 1, 3, 4).reshape(B, S, H, Dh)
    lse = lse.reshape(B, r, S // r, H).transpose(0, 2, 1, 3).reshape(B, S, H)
    return o, lse


def nsa_compress(x, w1, w2, pos):
    B, S, Hkv, Dh = x.shape
    ch = x.reshape(B, S // NSA_CMP_STRIDE, NSA_CMP_STRIDE, Hkv, Dh)
    blocks = jnp.concatenate([ch[:, :-1], ch[:, 1:]], axis=2)
    blocks = blocks + pos[None, None, :, None, :]
    ncmp = blocks.shape[1]
    flat = blocks.transpose(0, 1, 3, 2, 4).reshape(B, ncmp, Hkv, NSA_CMP_BLK * Dh)
    return jax.nn.gelu(flat @ w1) @ w2


def nsa_compressed_and_selected(q, kc, vc, ks, vs, slopes):
    B, S, H, Dh = q.shape
    Hkv = ks.shape[2]
    G = H // Hkv
    ncmp = kc.shape[1]
    nsel = S // NSA_SEL_BLK
    n_pick = min(NSA_N_SEL, nsel)
    nblk = S // QBLK
    cmp_start = jnp.arange(ncmp) * NSA_CMP_STRIDE
    cmp_end = cmp_start + NSA_CMP_BLK - 1
    sel_start = jnp.arange(nsel) * NSA_SEL_BLK
    overlap = ((cmp_start[:, None] < sel_start[None, :] + NSA_SEL_BLK)
               & (cmp_start[:, None] + NSA_CMP_BLK > sel_start[None, :])).astype(jnp.float32)
    slopes_kg = slopes.reshape(Hkv, G)
    kcf = kc.astype(jnp.float32)
    vcf = vc.astype(jnp.float32)
    kT = ks.transpose(0, 2, 1, 3)
    vT = vs.transpose(0, 2, 1, 3)
    bidx = jnp.arange(B)[:, None, None, None]
    hidx = jnp.arange(Hkv)[None, :, None, None]
    jsel = jnp.arange(nsel)[None, :]
    qb = q.reshape(B, nblk, QBLK, Hkv, G, Dh).transpose(1, 0, 2, 3, 4, 5)

    def block(args):
        n, qn = args
        t = n * QBLK + jnp.arange(QBLK)
        qf = qn.astype(jnp.float32)
        s = jnp.einsum('bikgd,bjkd->bkgij', qf, kcf) * ATTN_SCALE
        dist = (t[:, None] - cmp_end[None, :]).astype(jnp.float32)
        valid = dist >= 0
        s = jnp.where(valid, s - slopes_kg[:, :, None, None] * dist, NEG)
        m = jnp.max(s, axis=-1, keepdims=True)
        e = jnp.where(valid, jnp.exp(s - m), 0.0)
        den = jnp.sum(e, axis=-1, keepdims=True)
        p = e / jnp.where(den > 0, den, 1.0)
        o_cmp = jnp.einsum('bkgij,bjkd->bikgd', p, vcf)
        imp = jnp.einsum('bkgij,js->bkis', p, overlap)
        cur = (t // NSA_SEL_BLK)[:, None]
        forced = (jsel == 0) | (jsel == cur) | (jsel == cur - 1)
        allowed = jsel <= cur
        score = jnp.where(forced, FORCE_SCORE, jnp.where(allowed, imp, -1.0))
        _, idx = lax.top_k(score, n_pick)
        pos = (idx[..., None] * NSA_SEL_BLK + jnp.arange(NSA_SEL_BLK)).reshape(B, Hkv, QBLK, n_pick * NSA_SEL_BLK)
        ksel = kT[bidx, hidx, pos].astype(jnp.float32)
        vsel = vT[bidx, hidx, pos].astype(jnp.float32)
        s2 = jnp.einsum('bikgd,bkitd->bkgit', qf, ksel) * ATTN_SCALE
        d2 = (t[None, None, :, None] - pos)[:, :, None]
        s2 = s2 - slopes_kg[None, :, :, None, None] * d2.astype(jnp.float32)
        s2 = jnp.where(d2 >= 0, s2, NEG)
        p2 = jax.nn.softmax(s2, axis=-1)
        o_sel = jnp.einsum('bkgit,bkitd->bikgd', p2, vsel)
        return o_cmp, o_sel

    o_cmp, o_sel = lax.map(block, (jnp.arange(nblk), qb))
    o_cmp = o_cmp.transpose(1, 0, 2, 3, 4, 5).reshape(B, S, H, Dh).astype(q.dtype)
    o_sel = o_sel.transpose(1, 0, 2, 3, 4, 5).reshape(B, S, H, Dh).astype(q.dtype)
    return o_cmp, o_sel


def setup_inputs(seed: int = 0) -> dict:
    key = jax.random.key(seed)
    ks = jax.random.split(key, 11)
    x = jax.random.normal(ks[0], (BATCH, SEQ, D_MODEL), jnp.float32)
    w_in = jax.random.normal(ks[1], (DEPTH, D_MODEL, IN_COLS), jnp.float32) * D_MODEL ** -0.5
    b_in = 0.02 * jax.random.normal(ks[2], (DEPTH, IN_COLS), jnp.float32)
    w_cmp1 = jax.random.normal(ks[3], (DEPTH, 2, NSA_CMP_BLK * HD, NSA_CMP_HIDDEN), jnp.float32) * (NSA_CMP_BLK * HD) ** -0.5
    w_cmp2 = jax.random.normal(ks[4], (DEPTH, 2, NSA_CMP_HIDDEN, HD), jnp.float32) * NSA_CMP_HIDDEN ** -0.5
    cmp_pos = 0.02 * jax.random.normal(ks[5], (DEPTH, 2, NSA_CMP_BLK, HD), jnp.float32)
    sinks = 0.5 * jax.random.normal(ks[6], (DEPTH, C_HEADS), jnp.float32)
    w_branch = jax.random.normal(ks[7], (DEPTH, N_BRANCH, BRANCH_W, D_MODEL), jnp.float32) * (BRANCH_W ** -0.5 * DEEPNORM_BETA)
    w_out = jax.random.normal(ks[8], (DEPTH, D_MODEL, D_MODEL), jnp.float32) * (D_MODEL ** -0.5 * DEEPNORM_BETA)
    ln_g = 1.0 + 0.02 * jax.random.normal(ks[9], (DEPTH, D_MODEL), jnp.float32)
    ln_b = 0.02 * jax.random.normal(ks[10], (DEPTH, D_MODEL), jnp.float32)
    return {"x": x, "w_in": w_in, "b_in": b_in, "w_cmp1": w_cmp1, "w_cmp2": w_cmp2,
            "cmp_pos": cmp_pos, "sinks": sinks, "w_branch": w_branch, "w_out": w_out,
            "ln_g": ln_g, "ln_b": ln_b}


def reference(x, w_in, b_in, w_cmp1, w_cmp2, cmp_pos, sinks, w_branch, w_out, ln_g, ln_b):
    B, S, _ = x.shape
    split_at = np.cumsum(IN_WIDTHS)[:-1].tolist()
    a_slopes = alibi_slopes(A_GROUPS * A_HEADS).reshape(A_GROUPS, A_HEADS)
    b_slopes = alibi_slopes(B_HEADS)
    c_slopes = alibi_slopes(C_HEADS)
    for l in range(DEPTH):
        h = x @ w_in[l] + b_in[l]
        (aq, ak, av, ag, bq, bck, bcv, bsk, bsv, bwk, bwv, bg, bgate,
         cq, ck, cv, cg, mg) = jnp.split(h, split_at, axis=-1)

        aq = aq.reshape(B, S, A_GROUPS, A_HEADS, HD)
        ak = ak.reshape(B, S, A_GROUPS, A_HEADS, HD)
        av = av.reshape(B, S, A_GROUPS, A_HEADS, HD)
        outs, lses = [], []
        for gi, (win, dil) in enumerate(A_PATTERNS):
            o, lse = dilated_attention(aq[:, :, gi], ak[:, :, gi], av[:, :, gi], a_slopes[gi], win, dil)
            outs.append(o)
            lses.append(lse)
        wts = jax.nn.softmax(jnp.stack(lses), axis=0)
        ya = jnp.sum(wts[..., None] * jnp.stack(outs).astype(jnp.float32), axis=0)
        ya = ya.reshape(B, S, BRANCH_W).astype(x.dtype) * jax.nn.silu(ag)

        bq4 = bq.reshape(B, S, B_HEADS, HD)
        kcmp = nsa_compress(bck.reshape(B, S, B_KV, HD), w_cmp1[l, 0], w_cmp2[l, 0], cmp_pos[l, 0])
        vcmp = nsa_compress(bcv.reshape(B, S, B_KV, HD), w_cmp1[l, 1], w_cmp2[l, 1], cmp_pos[l, 1])
        o_cmp, o_sel = nsa_compressed_and_selected(bq4, kcmp, vcmp, bsk.reshape(B, S, B_KV, HD),
                                                   bsv.reshape(B, S, B_KV, HD), b_slopes)
        o_win, _ = banded_attention(bq4, bwk.reshape(B, S, B_KV, HD), bwv.reshape(B, S, B_KV, HD),
                                    b_slopes, NSA_WINDOW - 1, 1)
        gts = jax.nn.sigmoid(bgate.reshape(B, S, B_HEADS, 3))
        yb = gts[..., 0:1] * o_cmp + gts[..., 1:2] * o_sel + gts[..., 2:3] * o_win
        yb = yb.reshape(B, S, BRANCH_W).astype(x.dtype) * jax.nn.silu(bg)

        o_c, _ = banded_attention(cq.reshape(B, S, C_HEADS, HD), ck.reshape(B, S, C_KV, HD),
                                  cv.reshape(B, S, C_KV, HD), c_slopes, C_WINDOW - 1, 1, sinks=sinks[l])
        yc = o_c.reshape(B, S, BRANCH_W).astype(x.dtype) * jax.nn.silu(cg)

        mg = jax.nn.sigmoid(mg.reshape(B, S, N_BRANCH, D_MODEL))
        merged = (mg[:, :, 0] * (ya @ w_branch[l, 0])
                  + mg[:, :, 1] * (yb @ w_branch[l, 1])
                  + mg[:, :, 2] * (yc @ w_branch[l, 2]))
        y = (merged @ w_out[l]).astype(x.dtype)

        x = layer_norm(DEEPNORM_ALPHA * x + y, ln_g[l], ln_b[l])
    return x
```

```cpp
#include <hip/hip_runtime.h>
#include <hip/hip_cooperative_groups.h>
#include <cstdio>
#include <cstdint>
namespace cg = cooperative_groups;

typedef unsigned short u16;
typedef unsigned long long u64;
typedef __attribute__((ext_vector_type(8))) __bf16 bf16x8;
typedef __attribute__((ext_vector_type(2))) __bf16 bf16x2;
typedef __attribute__((ext_vector_type(4))) short s16x4;
typedef __attribute__((ext_vector_type(8))) short s16x8;
typedef __attribute__((ext_vector_type(2))) float f32x2;
typedef __attribute__((ext_vector_type(4))) float f32x4;
typedef __attribute__((ext_vector_type(16))) float f32x16;
typedef __attribute__((ext_vector_type(4))) unsigned u32x4;
typedef __attribute__((ext_vector_type(2))) unsigned u32x2;

constexpr int SEQ = 8192, NTOK = 16384, DM = 1024, DEPTH = 4;
constexpr int HC = 11392;
constexpr int C_AQ = 0, C_AK = 1536, C_AV = 3072, C_AG = 4608, C_BQ = 5120, C_BCK = 5632, C_BCV = 5760,
              C_BSK = 5888, C_BSV = 6016, C_BWK = 6144, C_BWV = 6272, C_BG = 6400, C_CQ = 6912, C_CK = 7424,
              C_CV = 7552, C_CG = 7680, C_MG = 8192, C_BGATE = 11264;
constexpr int IN_COLS = 11288;
constexpr float LOG2E = 1.4426950408889634f;
constexpr float C1 = 0.125f * LOG2E;
constexpr float NEGB = -1e30f;
constexpr float DN_ALPHA = 1.681792830507429f;
constexpr int LDT = 72;
constexpr int SMEM_BYTES = 73728;
constexpr int IMPS = 132;

struct Params {
  const float *x, *w_in, *b_in, *w_cmp1, *w_cmp2, *cmp_pos, *sinks, *w_branch, *w_out, *ln_g, *ln_b;
  float* out;
  u16 *xb, *wt_in, *w1t, *w2t, *wbt, *wot, *h, *oA, *owin, *y, *merged, *kcmp, *vcmp;
  float *bias, *lseA, *z;
  unsigned* ctr;
  unsigned* xbar;
};

__device__ __forceinline__ int tidx() {
  int t = threadIdx.x;
  asm volatile("" : "+v"(t));
  return t;
}
__device__ __forceinline__ float bf2f(u16 v) { return __uint_as_float(((unsigned)v) << 16); }
__device__ __forceinline__ unsigned pack2(float a, float b) {
  f32x2 f = {a, b};
  bf16x2 c = __builtin_convertvector(f, bf16x2);
  return __builtin_bit_cast(unsigned, c);
}
__device__ __forceinline__ u16 f2bf(float a) { return (u16)(pack2(a, 0.f) & 0xffffu); }
__device__ __forceinline__ float lo_f(unsigned v) { return __uint_as_float(v << 16); }
__device__ __forceinline__ float hi_f(unsigned v) { return __uint_as_float(v & 0xffff0000u); }
__device__ __forceinline__ float ex2(float x) { return __builtin_amdgcn_exp2f(x); }
__device__ __forceinline__ float sigmoidf_(float x) { return __builtin_amdgcn_rcpf(1.f + __expf(-x)); }
__device__ __forceinline__ float siluf_(float x) { return x * __builtin_amdgcn_rcpf(1.f + __expf(-x)); }
__device__ __forceinline__ float gelu_tanh(float x) {
  float u = 0.7978845608028654f * (x + 0.044715f * x * x * x);
  float t = 1.f - 2.f / (__expf(2.f * u) + 1.f);
  return 0.5f * x * (1.f + t);
}
__device__ __forceinline__ bf16x8 ld_frag(const u16* p) { return *reinterpret_cast<const bf16x8*>(p); }
__device__ __forceinline__ bf16x8 tr_frag(const u16* p0, const u16* p1) {
  s16x4 lo = __builtin_amdgcn_ds_read_tr16_b64_v4i16((__attribute__((address_space(3))) s16x4*)(p0));
  s16x4 hi = __builtin_amdgcn_ds_read_tr16_b64_v4i16((__attribute__((address_space(3))) s16x4*)(p1));
  s16x8 r = __builtin_shufflevector(lo, hi, 0, 1, 2, 3, 4, 5, 6, 7);
  return __builtin_bit_cast(bf16x8, r);
}
__device__ __forceinline__ f32x4 mfma16(bf16x8 a, bf16x8 b, f32x4 c) {
  return __builtin_amdgcn_mfma_f32_16x16x32_bf16(a, b, c, 0, 0, 0);
}
__device__ __forceinline__ f32x16 mfma32(bf16x8 a, bf16x8 b, f32x16 c) {
  return __builtin_amdgcn_mfma_f32_32x32x16_bf16(a, b, c, 0, 0, 0);
}


__device__ __forceinline__ int next_item(unsigned* ctr, int* slot) {
  __syncthreads();
  if (tidx() == 0) *slot = (int)atomicAdd(ctr, 1u);
  __syncthreads();
  return *slot;
}

__device__ __forceinline__ int src_col_in(int n) {
  return n < 6912 ? n : (n < 11264 ? n + 24 : (n < 11288 ? n - 11264 + 6912 : -1));
}
__device__ __forceinline__ void transpose_tile(const float* __restrict__ src, int Nsrc, u16* __restrict__ dst, int K, int n0, int k0,
                               bool perm, float* tile) {
  const int tx = tidx() & 63, ty = tidx() >> 6;
  const int n = n0 + tx;
  const int sc = perm ? src_col_in(n) : n;
  float v[32];
#pragma unroll
  for (int i = 0; i < 32; ++i) {
    int kk = ty + 4 * i;
    v[i] = sc >= 0 ? src[(size_t)(k0 + kk) * Nsrc + sc] : 0.f;
  }
#pragma unroll
  for (int i = 0; i < 32; ++i) tile[(ty + 4 * i) * 65 + tx] = v[i];
  __syncthreads();
#pragma unroll
  for (int j = 0; j < 4; ++j) {
    int id = tidx() + 256 * j;
    int nn = id >> 4, kc = id & 15;
    uint4 o;
    o.x = pack2(tile[(kc * 8 + 0) * 65 + nn], tile[(kc * 8 + 1) * 65 + nn]);
    o.y = pack2(tile[(kc * 8 + 2) * 65 + nn], tile[(kc * 8 + 3) * 65 + nn]);
    o.z = pack2(tile[(kc * 8 + 4) * 65 + nn], tile[(kc * 8 + 5) * 65 + nn]);
    o.w = pack2(tile[(kc * 8 + 6) * 65 + nn], tile[(kc * 8 + 7) * 65 + nn]);
    *reinterpret_cast<uint4*>(dst + (size_t)(n0 + nn) * K + k0 + kc * 8) = o;
  }
  __syncthreads();
}

__device__ __forceinline__ void phase_prep(const Params& p, char* smem) {
  float* tile = reinterpret_cast<float*>(smem);
  const int NT_IN = HC / 64;
  const int n_in = DEPTH * NT_IN * 8;
  const int n_c1 = 8 * 4 * 16;
  const int n_c2 = 8 * 1 * 2;
  const int n_br = 12 * 16 * 4;
  const int n_wo = 4 * 16 * 8;
  const int total = n_in + n_c1 + n_c2 + n_br + n_wo;
  for (int idx = blockIdx.x; idx < total; idx += gridDim.x) {
    int i = idx;
    if (i < n_in) {
      int l = i / (NT_IN * 8), r = i % (NT_IN * 8);
      int nt = r / 8, kt = r % 8;
      transpose_tile(p.w_in + (size_t)l * DM * IN_COLS, IN_COLS, p.wt_in + (size_t)l * HC * DM, DM, nt * 64, kt * 128,
                     true, tile);
      continue;
    }
    i -= n_in;
    if (i < n_c1) {
      int mtx = i / 64, r = i % 64;
      int nt = r / 16, kt = r % 16;
      transpose_tile(p.w_cmp1 + (size_t)mtx * 2048 * 256, 256, p.w1t + (size_t)mtx * 256 * 2048, 2048, nt * 64, kt * 128,
                     false, tile);
      continue;
    }
    i -= n_c1;
    if (i < n_c2) {
      int mtx = i / 2, kt = i % 2;
      transpose_tile(p.w_cmp2 + (size_t)mtx * 256 * 64, 64, p.w2t + (size_t)mtx * 64 * 256, 256, 0, kt * 128, false, tile);
      continue;
    }
    i -= n_c2;
    if (i < n_br) {
      int mtx = i / 64, r = i % 64;
      int nt = r / 4, kt = r % 4;
      transpose_tile(p.w_branch + (size_t)mtx * 512 * 1024, 1024, p.wbt + (size_t)mtx * 1024 * 512, 512, nt * 64, kt * 128,
                     false, tile);
      continue;
    }
    i -= n_br;
    {
      int mtx = i / 128, r = i % 128;
      int nt = r / 8, kt = r % 8;
      transpose_tile(p.w_out + (size_t)mtx * 1024 * 1024, 1024, p.wot + (size_t)mtx * 1024 * 1024, 1024, nt * 64, kt * 128,
                     false, tile);
    }
  }
  if (blockIdx.x == 0) p.ctr[tidx()] = 0u;
  const size_t nchunk = (size_t)NTOK * DM / 8;
  for (size_t c = (size_t)blockIdx.x * 256 + tidx(); c < nchunk; c += (size_t)gridDim.x * 256) {
    const float4* s = reinterpret_cast<const float4*>(p.x + c * 8);
    float4 a = s[0], b = s[1];
    uint4 o;
    o.x = pack2(a.x, a.y); o.y = pack2(a.z, a.w); o.z = pack2(b.x, b.y); o.w = pack2(b.z, b.w);
    *reinterpret_cast<uint4*>(p.xb + c * 8) = o;
  }
  for (int c = blockIdx.x * 256 + tidx(); c < DEPTH * HC; c += gridDim.x * 256) {
    int l = c / HC, n = c % HC;
    int sc = src_col_in(n);
    p.bias[c] = sc >= 0 ? p.b_in[(size_t)l * IN_COLS + sc] : 0.f;
  }
}

constexpr int GLD = 64;
constexpr int GSTAGE = 256 * GLD;
template <int NN>
__device__ __forceinline__ void gemm_mainloop(const u16* __restrict__ A, int lda, const u16* __restrict__ B, int ldb,
                                              int K, f32x4 (&acc)[4][NN], u16* smem16) {
  const int tid = tidx(), lane = tid & 63, w = tid >> 6, wm = w >> 1, wn = w & 1;
  const int lr = tid >> 3, lc = (tid & 7) * 8;
  const int wofs = lr * GLD + (((tid & 7) ^ (lr & 7)) * 8);
  const int rph0 = (((lane >> 4) ^ (lane & 7)) * 8);
  u32x4 ra[4], rb[NN];
  const u16* Ap = A + (size_t)lr * lda + lc;
  const u16* Bp = B + (size_t)lr * ldb + lc;
#pragma unroll
  for (int i = 0; i < 4; ++i) ra[i] = *reinterpret_cast<const u32x4*>(Ap + (size_t)(32 * i) * lda);
#pragma unroll
  for (int i = 0; i < NN; ++i) rb[i] = *reinterpret_cast<const u32x4*>(Bp + (size_t)(32 * i) * ldb);
  const int nk = K >> 6;
  {
    u16* sA = smem16;
    u16* sB = smem16 + 128 * GLD;
#pragma unroll
    for (int i = 0; i < 4; ++i) *reinterpret_cast<u32x4*>(sA + 32 * i * GLD + wofs) = ra[i];
#pragma unroll
    for (int i = 0; i < NN; ++i) *reinterpret_cast<u32x4*>(sB + 32 * i * GLD + wofs) = rb[i];
  }
  if (nk > 1) {
#pragma unroll
    for (int i = 0; i < 4; ++i) ra[i] = *reinterpret_cast<const u32x4*>(Ap + (size_t)(32 * i) * lda + 64);
#pragma unroll
    for (int i = 0; i < NN; ++i) rb[i] = *reinterpret_cast<const u32x4*>(Bp + (size_t)(32 * i) * ldb + 64);
  }
  __syncthreads();
  for (int kt = 0; kt < nk; ++kt) {
    const u16* sA = smem16 + (kt & 1) * GSTAGE;
    const u16* sB = sA + 128 * GLD;
#pragma unroll
    for (int kk = 0; kk < 2; ++kk) {
      const int ph = rph0 ^ (kk * 32);
      bf16x8 a[4], b[NN];
#pragma unroll
      for (int m = 0; m < 4; ++m) a[m] = ld_frag(sA + (wm * 64 + m * 16 + (lane & 15)) * GLD + ph);
#pragma unroll
      for (int n = 0; n < NN; ++n) b[n] = ld_frag(sB + (wn * 16 * NN + n * 16 + (lane & 15)) * GLD + ph);
#pragma unroll
      for (int m = 0; m < 4; ++m)
#pragma unroll
        for (int n = 0; n < NN; ++n) acc[m][n] = mfma16(b[n], a[m], acc[m][n]);
    }
    if (kt + 1 < nk) {
      u16* dA = smem16 + ((kt + 1) & 1) * GSTAGE;
      u16* dB = dA + 128 * GLD;
#pragma unroll
      for (int i = 0; i < 4; ++i) *reinterpret_cast<u32x4*>(dA + 32 * i * GLD + wofs) = ra[i];
#pragma unroll
      for (int i = 0; i < NN; ++i) *reinterpret_cast<u32x4*>(dB + 32 * i * GLD + wofs) = rb[i];
    }
    if (kt + 2 < nk) {
      const int k0 = (kt + 2) << 6;
#pragma unroll
      for (int i = 0; i < 4; ++i) ra[i] = *reinterpret_cast<const u32x4*>(Ap + (size_t)(32 * i) * lda + k0);
#pragma unroll
      for (int i = 0; i < NN; ++i) rb[i] = *reinterpret_cast<const u32x4*>(Bp + (size_t)(32 * i) * ldb + k0);
    }
    __syncthreads();
  }
}

constexpr int WSTAGE = 384 * 32;
__device__ __forceinline__ void gemm_mainloop_wide(const u16* __restrict__ A, int lda, const u16* __restrict__ B,
                                                   int ldb, int K, f32x4 (&acc)[4][8], u16* smem16) {
  const int tid = tidx(), lane = tid & 63, w = tid >> 6, wm = w >> 1, wn = w & 1;
  const int lr = tid >> 2, lc = (tid & 3) * 8;
  const int wofs = lr * 32 + (((tid & 3) ^ ((4 - ((lr >> 2) & 3)) & 3)) * 8);
  const int rofs = (lane & 15) * 32 + (((lane >> 4) ^ ((4 - ((lane & 15) >> 2)) & 3)) * 8);
  u32x4 ra[2], rb[4];
  const u16* Ap = A + (size_t)lr * lda + lc;
  const u16* Bp = B + (size_t)lr * ldb + lc;
#pragma unroll
  for (int i = 0; i < 2; ++i) ra[i] = *reinterpret_cast<const u32x4*>(Ap + (size_t)(64 * i) * lda);
#pragma unroll
  for (int i = 0; i < 4; ++i) rb[i] = *reinterpret_cast<const u32x4*>(Bp + (size_t)(64 * i) * ldb);
  const int nk = K >> 5;
#pragma unroll
  for (int i = 0; i < 2; ++i) *reinterpret_cast<u32x4*>(smem16 + 64 * i * 32 + wofs) = ra[i];
#pragma unroll
  for (int i = 0; i < 4; ++i) *reinterpret_cast<u32x4*>(smem16 + (128 + 64 * i) * 32 + wofs) = rb[i];
#pragma unroll
  for (int i = 0; i < 2; ++i) ra[i] = *reinterpret_cast<const u32x4*>(Ap + (size_t)(64 * i) * lda + 32);
#pragma unroll
  for (int i = 0; i < 4; ++i) rb[i] = *reinterpret_cast<const u32x4*>(Bp + (size_t)(64 * i) * ldb + 32);
  __syncthreads();
  for (int kt = 0; kt < nk; ++kt) {
    const u16* sA = smem16 + (kt & 1) * WSTAGE;
    const u16* sB = sA + 128 * 32;
    bf16x8 a[4];
#pragma unroll
    for (int m = 0; m < 4; ++m) a[m] = ld_frag(sA + (wm * 64 + m * 16) * 32 + rofs);
#pragma unroll
    for (int nh = 0; nh < 2; ++nh) {
      bf16x8 b[4];
#pragma unroll
      for (int n = 0; n < 4; ++n) b[n] = ld_frag(sB + (wn * 128 + nh * 64 + n * 16) * 32 + rofs);
#pragma unroll
      for (int m = 0; m < 4; ++m)
#pragma unroll
        for (int n = 0; n < 4; ++n) acc[m][nh * 4 + n] = mfma16(b[n], a[m], acc[m][nh * 4 + n]);
    }
    if (kt + 1 < nk) {
      u16* d = smem16 + ((kt + 1) & 1) * WSTAGE;
#pragma unroll
      for (int i = 0; i < 2; ++i) *reinterpret_cast<u32x4*>(d + 64 * i * 32 + wofs) = ra[i];
#pragma unroll
      for (int i = 0; i < 4; ++i) *reinterpret_cast<u32x4*>(d + (128 + 64 * i) * 32 + wofs) = rb[i];
    }
    {
      const int k0 = ((kt + 2 < nk) ? kt + 2 : nk - 1) << 5;
#pragma unroll
      for (int i = 0; i < 2; ++i) ra[i] = *reinterpret_cast<const u32x4*>(Ap + (size_t)(64 * i) * lda + k0);
#pragma unroll
      for (int i = 0; i < 4; ++i) rb[i] = *reinterpret_cast<const u32x4*>(Bp + (size_t)(64 * i) * ldb + k0);
    }
    __syncthreads();
  }
}

constexpr int LDC = 136;
constexpr int LDCW = 264;
__device__ __forceinline__ void phase_gemm_in(const Params& p, int layer, char* smem) {
  u16* s16 = reinterpret_cast<u16*>(smem);
  const int tid = tidx(), lane = tid & 63, w = tid >> 6, wm = w >> 1, wn = w & 1;
  const u16* W = p.wt_in + (size_t)layer * HC * DM;
  const float* bias = p.bias + (size_t)layer * HC;
  const int xcd = blockIdx.x & 7, loc = blockIdx.x >> 3, nxl = gridDim.x >> 3;
  const int per_st = (loc < 64 && loc < nxl) ? (64 - loc + nxl - 1) / nxl : 0;
  const int n_main = ((88 - xcd + 7) / 8) * per_st;
  for (int u = 0; u < n_main; ++u) {
    const int st = xcd + 8 * (u / per_st), j = loc + (u % per_st) * nxl;
    const int mt = (st / 11) * 16 + (j & 15);
    const int nt = (st % 11) * 4 + (j >> 4);
    const int m0 = mt * 128, n0 = nt * 256;
    f32x4 acc[4][8];
#pragma unroll
    for (int m = 0; m < 4; ++m)
#pragma unroll
      for (int n = 0; n < 8; ++n) acc[m][n] = (f32x4){0.f, 0.f, 0.f, 0.f};
    gemm_mainloop_wide(p.xb + (size_t)m0 * DM, DM, W + (size_t)n0 * DM, DM, DM, acc, s16);
#pragma unroll
    for (int n = 0; n < 8; ++n) {
      const int col = wn * 128 + n * 16 + (lane >> 4) * 4;
      const float4 bv = *reinterpret_cast<const float4*>(bias + n0 + col);
#pragma unroll
      for (int m = 0; m < 4; ++m) {
        const int row = wm * 64 + m * 16 + (lane & 15);
        uint2 pk;
        pk.x = pack2(acc[m][n][0] + bv.x, acc[m][n][1] + bv.y);
        pk.y = pack2(acc[m][n][2] + bv.z, acc[m][n][3] + bv.w);
        *reinterpret_cast<uint2*>(s16 + row * LDCW + col) = pk;
      }
    }
    __syncthreads();
#pragma unroll
    for (int i = 0; i < 16; ++i) {
      const int id = tid + 256 * i;
      const int row = id >> 5, ch = id & 31;
      u32x4 v = *reinterpret_cast<const u32x4*>(s16 + row * LDCW + ch * 8);
      *reinterpret_cast<u32x4*>(p.h + (size_t)(m0 + row) * HC + n0 + ch * 8) = v;
    }
    __syncthreads();
  }
}

__device__ __forceinline__ void gemm_in_tail_item(const Params& p, int layer, int mt, char* smem) {
  u16* s16 = reinterpret_cast<u16*>(smem);
  const int tid = tidx(), lane = tid & 63, w = tid >> 6, wm = w >> 1, wn = w & 1;
  const u16* W = p.wt_in + (size_t)layer * HC * DM;
  const float* bias = p.bias + (size_t)layer * HC;
  const int m0 = mt * 128, n0 = C_BGATE;
  f32x4 acc[4][2];
#pragma unroll
  for (int m = 0; m < 4; ++m)
#pragma unroll
    for (int n = 0; n < 2; ++n) acc[m][n] = (f32x4){0.f, 0.f, 0.f, 0.f};
  gemm_mainloop<2>(p.xb + (size_t)m0 * DM, DM, W + (size_t)n0 * DM, DM, DM, acc, s16);
#pragma unroll
  for (int n = 0; n < 2; ++n) {
    const int col = n0 + wn * 32 + n * 16 + (lane >> 4) * 4;
    const float4 bv = *reinterpret_cast<const float4*>(bias + col);
#pragma unroll
    for (int m = 0; m < 4; ++m) {
      const int row = m0 + wm * 64 + m * 16 + (lane & 15);
      uint2 pk;
      pk.x = pack2(acc[m][n][0] + bv.x, acc[m][n][1] + bv.y);
      pk.y = pack2(acc[m][n][2] + bv.z, acc[m][n][3] + bv.w);
      *reinterpret_cast<uint2*>(p.h + (size_t)row * HC + col) = pk;
    }
  }
}

__device__ __forceinline__ void phase_gemm_branch(const Params& p, int layer, char* smem) {
  u16* s16 = reinterpret_cast<u16*>(smem);
  const int tid = tidx(), lane = tid & 63, w = tid >> 6, wm = w >> 1, wn = w & 1;
  const int xcd = blockIdx.x & 7, loc = blockIdx.x >> 3, nxl = gridDim.x >> 3;
  const int per_st = (loc < 64 && loc < nxl) ? (64 - loc + nxl - 1) / nxl : 0;
  for (int u = 0; u < per_st; ++u) {
    const int j = loc + u * nxl;
    const int mt = xcd * 16 + (j & 15), nt = j >> 4;
    const int m0 = mt * 128, n0 = nt * 256;
    f32x4 acc[4][8];
#pragma unroll
    for (int m = 0; m < 4; ++m)
#pragma unroll
      for (int n = 0; n < 8; ++n) acc[m][n] = (f32x4){0.f, 0.f, 0.f, 0.f};
    auto stage_gate = [&](int gb) {
#pragma unroll 1
      for (int hb = 0; hb < 2; ++hb) {
        u32x4 v[8];
#pragma unroll
        for (int i = 0; i < 8; ++i) {
          const int id = tid + 256 * (hb * 8 + i);
          v[i] = *reinterpret_cast<const u32x4*>(p.h + (size_t)(m0 + (id >> 5)) * HC + C_MG + gb * 1024 + n0 + (id & 31) * 8);
        }
#pragma unroll
        for (int i = 0; i < 8; ++i) {
          const int id = tid + 256 * (hb * 8 + i);
          *reinterpret_cast<u32x4*>(s16 + (id >> 5) * LDCW + (id & 31) * 8) = v[i];
        }
      }
    };
#pragma unroll 1
    for (int br = 0; br < 3; ++br) {
      const u16* A = p.y + ((size_t)br * NTOK + m0) * 512;
      const u16* B = p.wbt + ((size_t)(layer * 3 + br) * 1024 + n0) * 512;
      gemm_mainloop_wide(A, 512, B, 512, 512, acc, s16);
      stage_gate(br);
      __syncthreads();
#pragma unroll
      for (int n = 0; n < 8; ++n) {
        const int col = wn * 128 + n * 16 + (lane >> 4) * 4;
#pragma unroll
        for (int m = 0; m < 4; ++m) {
          const int row = wm * 64 + m * 16 + (lane & 15);
          const uint2 gv = *reinterpret_cast<const uint2*>(s16 + row * LDCW + col);
          acc[m][n][0] *= sigmoidf_(lo_f(gv.x));
          acc[m][n][1] *= sigmoidf_(hi_f(gv.x));
          acc[m][n][2] *= sigmoidf_(lo_f(gv.y));
          acc[m][n][3] *= sigmoidf_(hi_f(gv.y));
        }
      }
      __syncthreads();
      if (br < 2) {
        stage_gate(br + 1);
        __syncthreads();
#pragma unroll
        for (int n = 0; n < 8; ++n) {
          const int col = wn * 128 + n * 16 + (lane >> 4) * 4;
#pragma unroll
          for (int m = 0; m < 4; ++m) {
            const int row = wm * 64 + m * 16 + (lane & 15);
            const uint2 gv = *reinterpret_cast<const uint2*>(s16 + row * LDCW + col);
            acc[m][n][0] *= 1.f + __expf(-lo_f(gv.x));
            acc[m][n][1] *= 1.f + __expf(-hi_f(gv.x));
            acc[m][n][2] *= 1.f + __expf(-lo_f(gv.y));
            acc[m][n][3] *= 1.f + __expf(-hi_f(gv.y));
          }
        }
        __syncthreads();
      }
    }
#pragma unroll
    for (int n = 0; n < 8; ++n) {
      const int col = wn * 128 + n * 16 + (lane >> 4) * 4;
#pragma unroll
      for (int m = 0; m < 4; ++m) {
        const int row = wm * 64 + m * 16 + (lane & 15);
        uint2 pk;
        pk.x = pack2(acc[m][n][0], acc[m][n][1]);
        pk.y = pack2(acc[m][n][2], acc[m][n][3]);
        *reinterpret_cast<uint2*>(s16 + row * LDCW + col) = pk;
      }
    }
    __syncthreads();
#pragma unroll
    for (int i = 0; i < 16; ++i) {
      const int id = tid + 256 * i;
      const int row = id >> 5, ch = id & 31;
      const u32x4 v = *reinterpret_cast<const u32x4*>(s16 + row * LDCW + ch * 8);
      *reinterpret_cast<u32x4*>(p.merged + (size_t)(m0 + row) * DM + n0 + ch * 8) = v;
    }
    __syncthreads();
  }
}

__device__ __forceinline__ void phase_gemm_out(const Params& p, int layer, char* smem) {
  u16* s16 = reinterpret_cast<u16*>(smem);
  const int tid = tidx(), lane = tid & 63, w = tid >> 6, wm = w >> 1, wn = w & 1;
  const float* xres = layer == 0 ? p.x : p.out;
  const int xcd = blockIdx.x & 7, loc = blockIdx.x >> 3, nxl = gridDim.x >> 3;
  const int per_st = (loc < 64 && loc < nxl) ? (64 - loc + nxl - 1) / nxl : 0;
  for (int u = 0; u < per_st; ++u) {
    const int j = loc + u * nxl;
    const int mt = xcd * 16 + (j & 15), nt = j >> 4;
    const int m0 = mt * 128, n0 = nt * 256;
    f32x4 acc[4][8];
#pragma unroll
    for (int m = 0; m < 4; ++m)
#pragma unroll
      for (int n = 0; n < 8; ++n) acc[m][n] = (f32x4){0.f, 0.f, 0.f, 0.f};
    gemm_mainloop_wide(p.merged + (size_t)m0 * DM, DM, p.wot + ((size_t)layer * 1024 + n0) * 1024, 1024, 1024, acc, s16);
    float* sF = reinterpret_cast<float*>(smem);
#pragma unroll 1
    for (int half = 0; half < 2; ++half) {
      if (wm == half) {
#pragma unroll
        for (int n = 0; n < 8; ++n) {
          const int col = wn * 128 + n * 16 + (lane >> 4) * 4;
#pragma unroll
          for (int m = 0; m < 4; ++m) {
            const int row = m * 16 + (lane & 15);
            *reinterpret_cast<f32x4*>(sF + row * 260 + col) = acc[m][n];
          }
        }
      }
      __syncthreads();
#pragma unroll
      for (int i = 0; i < 16; ++i) {
        const int id = tid + 256 * i;
        const int row = id >> 6, c4 = (id & 63) * 4;
        const f32x4 a = *reinterpret_cast<const f32x4*>(sF + row * 260 + c4);
        const size_t g = (size_t)(m0 + half * 64 + row) * DM + n0 + c4;
        const f32x4 xv = *reinterpret_cast<const f32x4*>(xres + g);
        f32x4 o;
        o.x = DN_ALPHA * xv.x + a.x;
        o.y = DN_ALPHA * xv.y + a.y;
        o.z = DN_ALPHA * xv.z + a.z;
        o.w = DN_ALPHA * xv.w + a.w;
        *reinterpret_cast<f32x4*>(p.z + g) = o;
      }
      __syncthreads();
    }
  }
}

__device__ __forceinline__ void phase_ln(const Params& p, int layer) {
  const int lane = tidx() & 63, w = tidx() >> 6;
  const float* g = p.ln_g + (size_t)layer * DM;
  const float* bb = p.ln_b + (size_t)layer * DM;
  for (int idx = blockIdx.x; idx < NTOK / 8; idx += gridDim.x) {
    float4 v[2][4];
#pragma unroll
    for (int r = 0; r < 2; ++r) {
      const float* zr = p.z + (size_t)(idx * 8 + w * 2 + r) * DM;
#pragma unroll
      for (int i = 0; i < 4; ++i) v[r][i] = *reinterpret_cast<const float4*>(zr + lane * 4 + 256 * i);
    }
#pragma unroll
    for (int r = 0; r < 2; ++r) {
      const int row = idx * 8 + w * 2 + r;
      float s = 0.f;
#pragma unroll
      for (int i = 0; i < 4; ++i) s += v[r][i].x + v[r][i].y + v[r][i].z + v[r][i].w;
#pragma unroll
      for (int o = 32; o >= 1; o >>= 1) s += __shfl_xor(s, o);
      const float mu = s * (1.f / DM);
      float q = 0.f;
#pragma unroll
      for (int i = 0; i < 4; ++i) {
        float a = v[r][i].x - mu, b = v[r][i].y - mu, c = v[r][i].z - mu, d = v[r][i].w - mu;
        q += a * a + b * b + c * c + d * d;
      }
#pragma unroll
      for (int o = 32; o >= 1; o >>= 1) q += __shfl_xor(q, o);
      const float rs = rsqrtf(q * (1.f / DM) + 1e-5f);
#pragma unroll
      for (int i = 0; i < 4; ++i) {
        const int c = lane * 4 + 256 * i;
        float4 gg = *reinterpret_cast<const float4*>(g + c);
        float4 be = *reinterpret_cast<const float4*>(bb + c);
        float4 o;
        o.x = (v[r][i].x - mu) * rs * gg.x + be.x;
        o.y = (v[r][i].y - mu) * rs * gg.y + be.y;
        o.z = (v[r][i].z - mu) * rs * gg.z + be.z;
        o.w = (v[r][i].w - mu) * rs * gg.w + be.w;
        *reinterpret_cast<float4*>(p.out + (size_t)row * DM + c) = o;
        if (layer < DEPTH - 1) {
          uint2 ob;
          ob.x = pack2(o.x, o.y); ob.y = pack2(o.z, o.w);
          *reinterpret_cast<uint2*>(p.xb + (size_t)row * DM + c) = ob;
        }
      }
    }
  }
}

__device__ __forceinline__ void qk_tile(const u16* sK, const bf16x8 (&qf)[4], f32x16 (&st)[2], int lane) {
  const int r = lane & 31, hs = lane >> 5;
#pragma unroll
  for (int kb = 0; kb < 2; ++kb) {
    f32x16 c;
#pragma unroll
    for (int i = 0; i < 16; ++i) c[i] = 0.f;
#pragma unroll
    for (int ks = 0; ks < 4; ++ks) {
      bf16x8 a = ld_frag(sK + (kb * 32 + r) * LDT + ks * 16 + hs * 8);
      c = mfma32(a, qf[ks], c);
    }
    st[kb] = c;
  }
}
__device__ __forceinline__ void pv_tile(const u16* sV, const f32x16 (&pr)[2], f32x16 (&o)[2], int lane) {
  const int hs = lane >> 5, q = (lane & 15) >> 2, pp = lane & 3, cgp = (lane >> 4) & 1;
  bf16x8 pf[2][2];
#pragma unroll
  for (int kb = 0; kb < 2; ++kb)
#pragma unroll
    for (int s = 0; s < 2; ++s) {
      uint4 u;
      u.x = pack2(pr[kb][8 * s + 0], pr[kb][8 * s + 1]);
      u.y = pack2(pr[kb][8 * s + 2], pr[kb][8 * s + 3]);
      u.z = pack2(pr[kb][8 * s + 4], pr[kb][8 * s + 5]);
      u.w = pack2(pr[kb][8 * s + 6], pr[kb][8 * s + 7]);
      pf[kb][s] = __builtin_bit_cast(bf16x8, u);
    }
#pragma unroll
  for (int db = 0; db < 2; ++db)
#pragma unroll
    for (int kb = 0; kb < 2; ++kb)
#pragma unroll
      for (int s = 0; s < 2; ++s) {
        const int r0 = kb * 32 + 16 * s + 4 * hs;
        const u16* a0 = sV + (r0 + q) * LDT + db * 32 + cgp * 16 + pp * 4;
        bf16x8 a = tr_frag(a0, a0 + 8 * LDT);
        o[db] = mfma32(a, pf[kb][s], o[db]);
      }
}
__device__ __forceinline__ void load_tile64(u16* sT, const u16* __restrict__ src, size_t rs, int nvalid) {
#pragma unroll
  for (int i = 0; i < 2; ++i) {
    int id = tidx() + 256 * i;
    int row = id >> 3, ch = id & 7;
    uint4 v = make_uint4(0, 0, 0, 0);
    if (row < nvalid) v = *reinterpret_cast<const uint4*>(src + (size_t)row * rs + ch * 8);
    *reinterpret_cast<uint4*>(sT + row * LDT + ch * 8) = v;
  }
}

template <bool GUARD = true>
__device__ __forceinline__ void tile_ld(u32x4 (&r)[2], const u16* __restrict__ src, size_t rs, int nvalid, int tid) {
#pragma unroll
  for (int i = 0; i < 2; ++i) {
    const int id = tid + 256 * i;
    const int row = id >> 3, ch = id & 7;
    if (GUARD) {
      u32x4 v = {0u, 0u, 0u, 0u};
      if (row < nvalid) v = *reinterpret_cast<const u32x4*>(src + (size_t)row * rs + ch * 8);
      r[i] = v;
    } else {
      r[i] = *reinterpret_cast<const u32x4*>(src + (size_t)row * rs + ch * 8);
    }
  }
}
__device__ __forceinline__ void tile_st(u16* sT, const u32x4 (&r)[2], int tid) {
#pragma unroll
  for (int i = 0; i < 2; ++i) {
    const int id = tid + 256 * i;
    *reinterpret_cast<u32x4*>(sT + (id >> 3) * LDT + (id & 7) * 8) = r[i];
  }
}
__device__ __forceinline__ void add_bias(f32x16 (&st)[2], float sl, float b0) {
#pragma unroll
  for (int kb = 0; kb < 2; ++kb) {
    const float base = fmaf(sl, 32.f * (float)kb, b0);
#pragma unroll
    for (int r = 0; r < 16; ++r) {
      const float off = (float)((r & 3) + 8 * (r >> 2));
      st[kb][r] = fmaf(st[kb][r], C1, fmaf(sl, off, base));
    }
  }
}
__device__ __forceinline__ float softmax_step(f32x16 (&st)[2], float& mref, float& l) {
  float mx = NEGB;
#pragma unroll
  for (int kb = 0; kb < 2; ++kb)
#pragma unroll
    for (int r = 0; r < 16; ++r) mx = fmaxf(mx, st[kb][r]);
  float scale = 1.f;
  if (__any(mx > 64.f)) {
    mx = fmaxf(mx, __shfl_xor(mx, 32));
    const float d = fmaxf(mx, 0.f);
    scale = ex2(-d);
    mref += d;
    l *= scale;
#pragma unroll
    for (int kb = 0; kb < 2; ++kb)
#pragma unroll
      for (int r = 0; r < 16; ++r) st[kb][r] -= d;
  }
  float ps = 0.f;
#pragma unroll
  for (int kb = 0; kb < 2; ++kb)
#pragma unroll
    for (int r = 0; r < 16; ++r) {
      const float pv = ex2(st[kb][r]);
      st[kb][r] = pv;
      ps += pv;
    }
  l += ps;
  return scale;
}
__device__ __forceinline__ float dpp_xor1(float v) {
  return __builtin_bit_cast(float, __builtin_amdgcn_update_dpp(0, __builtin_bit_cast(int, v), 0xB1, 0xF, 0xF, true));
}
__device__ __forceinline__ float dpp_xor2(float v) {
  return __builtin_bit_cast(float, __builtin_amdgcn_update_dpp(0, __builtin_bit_cast(int, v), 0x4E, 0xF, 0xF, true));
}

__device__ __forceinline__ void compress_item(const Params& p, int layer, int kvsel, int tile, char* smem) {
  u16* sA = reinterpret_cast<u16*>(smem);
  u16* sW = sA + 32 * LDT;
  const int tid = tidx(), lane = tid & 63, w = tid >> 6;
  const u16* W1 = p.w1t + (size_t)(layer * 2 + kvsel) * 256 * 2048;
  const u16* W2 = p.w2t + (size_t)(layer * 2 + kvsel) * 64 * 256;
  const float* pos = p.cmp_pos + (size_t)(layer * 2 + kvsel) * 32 * 64;
  const int colbase = kvsel ? C_BCV : C_BCK;
  f32x4 acc[2][4];
#pragma unroll
  for (int m = 0; m < 2; ++m)
#pragma unroll
    for (int n = 0; n < 4; ++n) acc[m][n] = (f32x4){0.f, 0.f, 0.f, 0.f};
  const int ar = tid >> 3, ach = tid & 7;
  const int R = tile * 32 + ar;
  const int bk = R >> 9;
  int nn = R & 511;
  if (nn > 510) nn = 510;
  const u16* arow = p.h + ((size_t)((bk >> 1) * SEQ + 16 * nn)) * HC + colbase + (bk & 1) * 64 + ach * 8;
  const int wrow = tid >> 3, wch = (tid & 7) * 8;
  u32x4 w0[8], w1[8], h0, h1;
  f32x4 q0[2], q1[2];
  auto ldstage = [&](u32x4 (&wr)[8], u32x4& hr, f32x4 (&pr)[2], int i) {
    const int ic = i < 32 ? i : 31;
    hr = *reinterpret_cast<const u32x4*>(arow + (size_t)ic * HC);
    const f32x4* pp = reinterpret_cast<const f32x4*>(pos + ic * 64 + ach * 8);
    pr[0] = pp[0];
    pr[1] = pp[1];
#pragma unroll
    for (int j = 0; j < 8; ++j) wr[j] = *reinterpret_cast<const u32x4*>(W1 + (size_t)(wrow + 32 * j) * 2048 + ic * 64 + wch);
  };
  auto ststage = [&](const u32x4 (&wr)[8], const u32x4& hr, const f32x4 (&pr)[2]) {
    u32x4 o;
    o.x = pack2(lo_f(hr.x) + pr[0].x, hi_f(hr.x) + pr[0].y);
    o.y = pack2(lo_f(hr.y) + pr[0].z, hi_f(hr.y) + pr[0].w);
    o.z = pack2(lo_f(hr.z) + pr[1].x, hi_f(hr.z) + pr[1].y);
    o.w = pack2(lo_f(hr.w) + pr[1].z, hi_f(hr.w) + pr[1].w);
    *reinterpret_cast<u32x4*>(sA + ar * LDT + ach * 8) = o;
#pragma unroll
    for (int j = 0; j < 8; ++j) *reinterpret_cast<u32x4*>(sW + (wrow + 32 * j) * LDT + wch) = wr[j];
  };
  auto compute = [&]() {
#pragma unroll
    for (int kk = 0; kk < 2; ++kk) {
      bf16x8 a[2], b[4];
#pragma unroll
      for (int m = 0; m < 2; ++m) a[m] = ld_frag(sA + (m * 16 + (lane & 15)) * LDT + kk * 32 + (lane >> 4) * 8);
#pragma unroll
      for (int n = 0; n < 4; ++n) b[n] = ld_frag(sW + (w * 64 + n * 16 + (lane & 15)) * LDT + kk * 32 + (lane >> 4) * 8);
#pragma unroll
      for (int m = 0; m < 2; ++m)
#pragma unroll
        for (int n = 0; n < 4; ++n) acc[m][n] = mfma16(a[m], b[n], acc[m][n]);
    }
  };
  ldstage(w0, h0, q0, 0);
  asm volatile("" ::: "memory");
  ldstage(w1, h1, q1, 1);
  for (int i = 0; i < 32; i += 2) {
    ststage(w0, h0, q0);
    __syncthreads();
    ldstage(w0, h0, q0, i + 2);
    compute();
    __syncthreads();
    ststage(w1, h1, q1);
    __syncthreads();
    ldstage(w1, h1, q1, i + 3);
    compute();
    __syncthreads();
  }
  u16* sH = reinterpret_cast<u16*>(smem);
  u16* sW2 = sH + 32 * 264;
#pragma unroll
  for (int m = 0; m < 2; ++m)
#pragma unroll
    for (int n = 0; n < 4; ++n)
#pragma unroll
      for (int e = 0; e < 4; ++e) {
        int row = m * 16 + (lane >> 4) * 4 + e, col = w * 64 + n * 16 + (lane & 15);
        sH[row * 264 + col] = f2bf(gelu_tanh(acc[m][n][e]));
      }
#pragma unroll
  for (int j = 0; j < 8; ++j) {
    int id = tid + 256 * j;
    int row = id >> 5, ch = id & 31;
    uint4 v = *reinterpret_cast<const uint4*>(W2 + (size_t)row * 256 + ch * 8);
    *reinterpret_cast<uint4*>(sW2 + row * 264 + ch * 8) = v;
  }
  __syncthreads();
  f32x4 a2[2];
  a2[0] = (f32x4){0.f, 0.f, 0.f, 0.f};
  a2[1] = (f32x4){0.f, 0.f, 0.f, 0.f};
#pragma unroll
  for (int kk = 0; kk < 8; ++kk) {
    bf16x8 b = ld_frag(sW2 + (w * 16 + (lane & 15)) * 264 + kk * 32 + (lane >> 4) * 8);
#pragma unroll
    for (int m = 0; m < 2; ++m) {
      bf16x8 a = ld_frag(sH + (m * 16 + (lane & 15)) * 264 + kk * 32 + (lane >> 4) * 8);
      a2[m] = mfma16(a, b, a2[m]);
    }
  }
  u16* dst = kvsel ? p.vcmp : p.kcmp;
#pragma unroll
  for (int m = 0; m < 2; ++m)
#pragma unroll
    for (int e = 0; e < 4; ++e) {
      int row = m * 16 + (lane >> 4) * 4 + e, d = w * 16 + (lane & 15);
      int RR = tile * 32 + row;
      if ((RR & 511) < 511) dst[(size_t)RR * 64 + d] = f2bf(a2[m][e]);
    }
  __syncthreads();
}

struct BP {
  const u16 *Q, *K, *V, *gate;
  u16* O;
  float* LSE;
  size_t rs, os, ls;
  int qblk, window, mode, kstart, ntiles, has_sink;
  int gqa, sink_idx;
  float slope_l2;
};
__device__ __forceinline__ void banded_decode(const Params& p, int layer, int i, BP& d) {
  d.gate = nullptr; d.LSE = nullptr; d.rs = HC; d.os = 512; d.ls = 0; d.mode = 0; d.sink_idx = 0; d.has_sink = 0;
  d.gqa = 0;
  float slope;
  if (i < 1024) {
    const int b = i >> 9, kv = (i >> 8) & 1;
    d.qblk = i & 255;
    d.gqa = 1;
    const u16* base = p.h + (size_t)b * SEQ * HC;
    d.Q = base + C_BQ + kv * 256; d.K = base + C_BWK + kv * 64; d.V = base + C_BWV + kv * 64;
    d.window = 511;
    slope = exp2f(-(float)(kv * 4 + 1));
    d.O = p.owin + (size_t)b * SEQ * 512 + kv * 256;
  } else if (i < 4096) {
    i -= 1024;
    const int g = i >> 10, r = i & 1023;
    const int b = r >> 9, hh = (r >> 6) & 7, cb = r & 63;
    const int dil = g == 0 ? 1 : (g == 1 ? 4 : 16);
    const int bpc = 64 / dil;
    const int c = cb / bpc;
    d.qblk = cb % bpc;
    const u16* base = p.h + ((size_t)b * SEQ + c) * HC;
    d.Q = base + C_AQ + g * 512 + hh * 64; d.K = base + C_AK + g * 512 + hh * 64; d.V = base + C_AV + g * 512 + hh * 64;
    d.rs = (size_t)dil * HC;
    d.window = 128;
    slope = exp2f(-8.f * (float)(g * 8 + hh + 1) / 24.f) * (float)dil;
    d.O = p.oA + ((size_t)g * NTOK + (size_t)b * SEQ + c) * 512 + hh * 64;
    d.os = (size_t)dil * 512;
    d.LSE = p.lseA + ((size_t)g * NTOK + (size_t)b * SEQ + c) * 8 + hh;
    d.ls = (size_t)dil * 8;
  } else {
    i -= 4096;
    const int b = i >> 9, kv = (i >> 8) & 1;
    d.qblk = i & 255;
    d.gqa = 1;
    const u16* base = p.h + (size_t)b * SEQ * HC;
    d.Q = base + C_CQ + kv * 256; d.K = base + C_CK + kv * 64; d.V = base + C_CV + kv * 64;
    d.window = 127;
    slope = exp2f(-(float)(kv * 4 + 1));
    d.has_sink = 1;
    d.sink_idx = layer * 8 + kv * 4;
    d.mode = 1;
    d.O = p.y + ((size_t)2 * NTOK + (size_t)b * SEQ) * 512 + kv * 256;
    d.gate = base + C_CG + kv * 256;
  }
  d.slope_l2 = slope * LOG2E;
  if (d.gqa) {
    const int q0 = d.qblk * 32, lo = q0 - d.window;
    const int ks = lo > 0 ? (lo & ~63) : 0;
    int nt = (((q0 + 32 + 63) & ~63) - ks) >> 6;
    if (nt < 2) nt = 2;
    d.kstart = ks;
    d.ntiles = nt;
  } else {
    const int nb = (d.window + 127) >> 7;
    int ks = d.qblk * 128 - nb * 128;
    if (ks < 0) ks = 0;
    d.kstart = ks;
    d.ntiles = (d.qblk * 128 + 128 - ks) >> 6;
  }
}

__device__ __forceinline__ void phase_attn1(const Params& p, int layer, char* smem) {
  int* slot = reinterpret_cast<int*>(smem + SMEM_BYTES);
  unsigned* ctrA = p.ctr + layer * 4;
  unsigned* ctrB = ctrA + 1;
  for (;;) {
    const int i = next_item(ctrA, slot);
    if (i >= 256) break;
    if (i < 128) compress_item(p, layer, i >> 6, i & 63, smem);
    else gemm_in_tail_item(p, layer, i - 128, smem);
  }
  const int NBI = 5120;
  u16* sbase = reinterpret_cast<u16*>(smem);
  int gt = 0;
  const int tid = tidx(), lane = tid & 63, w = tid >> 6, hs = lane >> 5;
  int cur = next_item(ctrB, slot);
  int nxt = NBI;
  if (cur < NBI) nxt = next_item(ctrB, slot);
  BP bp;
  u32x4 ka[2], va[2], kb2[2], vb2[2];
  bf16x8 qf[4], qfn[4];
  f32x16 o[2];
  float m = 0.f, l = 0.f;
  int ti = 0;
  if (cur < NBI) {
    banded_decode(p, layer, cur, bp);
    tile_ld<false>(ka, bp.K + (size_t)bp.kstart * bp.rs, bp.rs, 64, tid);
    tile_ld<false>(va, bp.V + (size_t)bp.kstart * bp.rs, bp.rs, 64, tid);
    const int qp0 = (bp.gqa ? bp.qblk * 32 : bp.qblk * 128 + w * 32) + (lane & 31);
    const int hq0 = bp.gqa ? w * 64 : 0;
#pragma unroll
    for (int ks = 0; ks < 4; ++ks) qfn[ks] = ld_frag(bp.Q + hq0 + (size_t)qp0 * bp.rs + ks * 16 + hs * 8);
    asm volatile("" ::: "memory");
    tile_ld<false>(kb2, bp.K + (size_t)(bp.kstart + 64) * bp.rs, bp.rs, 64, tid);
    tile_ld<false>(vb2, bp.V + (size_t)(bp.kstart + 64) * bp.rs, bp.rs, 64, tid);
  }
  auto step = [&](u32x4 (&kr)[2], u32x4 (&vr)[2]) {
    const int qw0 = bp.gqa ? bp.qblk * 32 : bp.qblk * 128 + w * 32;
    const int qpos = qw0 + (lane & 31);
    const int hof = bp.gqa ? w * 64 : 0;
    const float slope_w = bp.gqa ? bp.slope_l2 * (1.f / (float)(1 << w)) : bp.slope_l2;
    if (ti == 0) {
#pragma unroll
      for (int ks = 0; ks < 4; ++ks) qf[ks] = qfn[ks];
#pragma unroll
      for (int i = 0; i < 16; ++i) { o[0][i] = 0.f; o[1][i] = 0.f; }
      m = 0.f; l = 0.f;
    }
    u16* sK = sbase + (gt & 1) * (128 * LDT);
    u16* sV = sK + 64 * LDT;
    tile_st(sK, kr, tid);
    tile_st(sV, vr, tid);
    __syncthreads();
    if (ti == 0 && tid == 0) *slot = (int)atomicAdd(ctrB, 1u);
    const int kt0 = bp.kstart + ti * 64;
    {
      const int t2 = ti + 2;
      if (t2 < bp.ntiles) {
        tile_ld<false>(kr, bp.K + (size_t)(bp.kstart + t2 * 64) * bp.rs, bp.rs, 64, tid);
        tile_ld<false>(vr, bp.V + (size_t)(bp.kstart + t2 * 64) * bp.rs, bp.rs, 64, tid);
      } else if (nxt < NBI) {
        BP bn;
        banded_decode(p, layer, nxt, bn);
        const int tn = t2 - bp.ntiles;
        tile_ld<false>(kr, bn.K + (size_t)(bn.kstart + tn * 64) * bn.rs, bn.rs, 64, tid);
        tile_ld<false>(vr, bn.V + (size_t)(bn.kstart + tn * 64) * bn.rs, bn.rs, 64, tid);
        if (tn == 0) {
          const int qpn = (bn.gqa ? bn.qblk * 32 : bn.qblk * 128 + w * 32) + (lane & 31);
          const int hqn = bn.gqa ? w * 64 : 0;
#pragma unroll
          for (int ks = 0; ks < 4; ++ks) qfn[ks] = ld_frag(bn.Q + hqn + (size_t)qpn * bn.rs + ks * 16 + hs * 8);
        }
      }
    }
    if (kt0 <= qw0 + 31 && kt0 + 63 >= qw0 - bp.window) {
      f32x16 st[2];
      qk_tile(sK, qf, st, lane);
      add_bias(st, slope_w, slope_w * (float)(kt0 + 4 * hs - qpos) - m);
      {
        const int d0 = qpos - kt0 - 4 * hs;
        if (kt0 + 63 > qw0) {
#pragma unroll
          for (int kb = 0; kb < 2; ++kb)
#pragma unroll
            for (int r = 0; r < 16; ++r)
              st[kb][r] = (kb * 32 + (r & 3) + 8 * (r >> 2) <= d0) ? st[kb][r] : NEGB;
        }
        if (kt0 < qw0 + 31 - bp.window) {
          const int dlo = d0 - bp.window;
#pragma unroll
          for (int kb = 0; kb < 2; ++kb)
#pragma unroll
            for (int r = 0; r < 16; ++r)
              st[kb][r] = (kb * 32 + (r & 3) + 8 * (r >> 2) >= dlo) ? st[kb][r] : NEGB;
        }
      }
      const float alpha = softmax_step(st, m, l);
      if (__any(alpha != 1.f)) {
#pragma unroll
        for (int i = 0; i < 16; ++i) { o[0][i] *= alpha; o[1][i] *= alpha; }
      }
      pv_tile(sV, st, o, lane);
    }
    ++gt;
    if (ti + 1 < bp.ntiles) {
      ++ti;
    } else {
      float lt = l + __shfl_xor(l, 32);
      if (bp.has_sink) lt += ex2(p.sinks[bp.sink_idx + w] * LOG2E - m);
      const float inv = 1.f / lt;
      if (bp.LSE != nullptr && hs == 0) bp.LSE[(size_t)qpos * bp.ls] = m + __log2f(lt);
      u16* sO = sbase + 2 * (128 * LDT) + w * (32 * LDT);
#pragma unroll
      for (int db = 0; db < 2; ++db)
#pragma unroll
        for (int q4 = 0; q4 < 4; ++q4) {
          const int d0 = db * 32 + 8 * q4 + 4 * hs;
          float v0 = o[db][4 * q4 + 0] * inv, v1 = o[db][4 * q4 + 1] * inv, v2 = o[db][4 * q4 + 2] * inv,
                v3 = o[db][4 * q4 + 3] * inv;
          if (bp.mode == 1) {
            uint2 gv = *reinterpret_cast<const uint2*>(bp.gate + hof + (size_t)qpos * bp.rs + d0);
            v0 *= siluf_(lo_f(gv.x)); v1 *= siluf_(hi_f(gv.x)); v2 *= siluf_(lo_f(gv.y)); v3 *= siluf_(hi_f(gv.y));
          }
          uint2 ov;
          ov.x = pack2(v0, v1); ov.y = pack2(v2, v3);
          *reinterpret_cast<uint2*>(sO + (lane & 31) * LDT + d0) = ov;
        }
      asm volatile("s_waitcnt lgkmcnt(0)" ::: "memory");
#pragma unroll
      for (int i = 0; i < 4; ++i) {
        const int row = (lane >> 3) + 8 * i, ch = lane & 7;
        const u32x4 v = *reinterpret_cast<const u32x4*>(sO + row * LDT + ch * 8);
        *reinterpret_cast<u32x4*>(bp.O + hof + (size_t)(qw0 + row) * bp.os + ch * 8) = v;
      }
      const int nn = *slot;
      cur = nxt;
      nxt = nn;
      ti = 0;
      if (cur < NBI) banded_decode(p, layer, cur, bp);
    }
  };
  while (cur < NBI) {
    step(ka, va);
    if (cur >= NBI) break;
    step(kb2, vb2);
  }
  __syncthreads();
}

__device__ __forceinline__ void nsa_item(const Params& p, int b, int kv, int chunk, char* smem) {
  u16* sbase = reinterpret_cast<u16*>(smem);
  int gt = 0;
  float* impAll = reinterpret_cast<float*>(smem + 36864);
  u64* selmask = reinterpret_cast<u64*>(smem + 36864 + 16896);
  u64* unionm = selmask + 64;
  const int tid = tidx(), lane = tid & 63, w = tid >> 6;
  const int hs = lane >> 5, n = lane & 31, g = n & 3, qi = n >> 2;
  const int head = kv * 4 + g;
  const int t0 = chunk * 32;
  const int t = t0 + 8 * w + qi;
  const int cur = t0 >> 6;
  const float slope_l2 = exp2f(-(float)(head + 1)) * LOG2E;
  float* impw = impAll + w * 8 * IMPS;
  unsigned* keyw = reinterpret_cast<unsigned*>(impw);
  const u16* hrow = p.h + ((size_t)b * SEQ + t) * HC;
  bf16x8 qf[4];
#pragma unroll
  for (int ks = 0; ks < 4; ++ks) qf[ks] = ld_frag(hrow + C_BQ + head * 64 + ks * 16 + hs * 8);
  for (int i = lane; i < 8 * IMPS; i += 64) impw[i] = 0.f;

  const u16* kc = p.kcmp + (size_t)(b * 2 + kv) * 512 * 64;
  const u16* vc = p.vcmp + (size_t)(b * 2 + kv) * 512 * 64;
  const int ncmp = 2 * chunk + 1;
  const int ntile = (ncmp + 63) >> 6;
  const int jmax = (t - 31) >> 4;
  const int jmax_w = (t0 + 8 * w - 31) >> 4;
  const float sl16 = 16.f * slope_l2;
  const float cb = slope_l2 * (float)(31 - t);
  u32x4 kr[2], vr[2];
  float m = 0.f, l = 0.f;
  tile_ld(kr, kc, 64, 511, tid);
  for (int tl = 0; tl < ntile; ++tl, ++gt) {
    const int j0 = tl * 64;
    u16* sK = sbase + (gt & 1) * (128 * LDT);
    tile_st(sK, kr, tid);
    __syncthreads();
    if (tl + 1 < ntile) tile_ld(kr, kc + (size_t)(j0 + 64) * 64, 64, 511 - (j0 + 64), tid);
    else { tile_ld(kr, kc, 64, 511, tid); tile_ld(vr, vc, 64, 511, tid); }
    {
      f32x16 st[2];
      qk_tile(sK, qf, st, lane);
      add_bias(st, sl16, fmaf(sl16, (float)(j0 + 4 * hs), cb) - m);
      if (j0 + 63 > jmax_w) {
        const int lim = jmax - j0 - 4 * hs;
#pragma unroll
        for (int kb = 0; kb < 2; ++kb)
#pragma unroll
          for (int r = 0; r < 16; ++r)
            st[kb][r] = (kb * 32 + (r & 3) + 8 * (r >> 2) <= lim) ? st[kb][r] : NEGB;
      }
      (void)softmax_step(st, m, l);
    }
  }
  l += __shfl_xor(l, 32);
  const float invl = l > 0.f ? 1.f / l : 1.f;
  const float mref = m;
  f32x16 ocmp[2];
#pragma unroll
  for (int i = 0; i < 16; ++i) { ocmp[0][i] = 0.f; ocmp[1][i] = 0.f; }
  for (int tl = 0; tl < ntile; ++tl, ++gt) {
    const int j0 = tl * 64;
    u16* sK = sbase + (gt & 1) * (128 * LDT);
    u16* sV = sK + 64 * LDT;
    tile_st(sK, kr, tid);
    tile_st(sV, vr, tid);
    __syncthreads();
    if (tl + 1 < ntile) {
      tile_ld(kr, kc + (size_t)(j0 + 64) * 64, 64, 511 - (j0 + 64), tid);
      tile_ld(vr, vc + (size_t)(j0 + 64) * 64, 64, 511 - (j0 + 64), tid);
    } else {
      tile_ld<false>(kr, p.h + (size_t)b * SEQ * HC + C_BSK + kv * 64, HC, 64, tid);
      tile_ld<false>(vr, p.h + (size_t)b * SEQ * HC + C_BSV + kv * 64, HC, 64, tid);
    }
    {
      f32x16 st[2];
      qk_tile(sK, qf, st, lane);
      add_bias(st, sl16, fmaf(sl16, (float)(j0 + 4 * hs), cb) - mref);
      if (j0 + 63 > jmax_w) {
        const int lim = jmax - j0 - 4 * hs;
#pragma unroll
        for (int kb = 0; kb < 2; ++kb)
#pragma unroll
          for (int r = 0; r < 16; ++r)
            st[kb][r] = (kb * 32 + (r & 3) + 8 * (r >> 2) <= lim) ? st[kb][r] : NEGB;
      }
#pragma unroll
      for (int kb = 0; kb < 2; ++kb)
#pragma unroll
        for (int r = 0; r < 16; ++r) st[kb][r] = ex2(st[kb][r]) * invl;
#pragma unroll
      for (int kb = 0; kb < 2; ++kb)
#pragma unroll
        for (int q4 = 0; q4 < 4; ++q4) {
          float last = st[kb][4 * q4 + 3];
          float sum4 = st[kb][4 * q4] + st[kb][4 * q4 + 1] + st[kb][4 * q4 + 2] + last;
          sum4 += dpp_xor1(sum4);
          sum4 += dpp_xor2(sum4);
          last += dpp_xor1(last);
          last += dpp_xor2(last);
          const int sidx = (j0 + kb * 32 + 8 * q4 + 4 * hs) >> 2;
          if (g == 0) impw[qi * IMPS + sidx] += sum4;
          if (g == 0 && sidx + 1 < 128) impw[qi * IMPS + sidx + 1] += last;
        }
      pv_tile(sV, st, ocmp, lane);
    }
  }
  for (int q = 0; q < 8; ++q) {
#pragma unroll
    for (int hh = 0; hh < 2; ++hh) {
      const int s = lane + 64 * hh;
      float v = impw[q * IMPS + s];
      const bool forced = (s == 0) || (s == cur) || (s == cur - 1);
      v = forced ? 1e4f : v;
      unsigned key = (__float_as_uint(v) & 0xffffff80u) | (unsigned)(127 - s);
      if (s > cur) key = 0u;
      keyw[q * IMPS + s] = key;
    }
  }
  u64 ulo = 0, uhi = 0;
  const int n4 = (cur >> 2) + 1;
  for (int q = 0; q < 8; ++q) {
    const unsigned k0 = keyw[q * IMPS + lane], k1 = keyw[q * IMPS + lane + 64];
    int r0 = 0, r1 = 0;
    const uint4* kp = reinterpret_cast<const uint4*>(keyw + q * IMPS);
#pragma unroll 4
    for (int s4 = 0; s4 < n4; ++s4) {
      uint4 x = kp[s4];
      r0 += (x.x > k0) + (x.y > k0) + (x.z > k0) + (x.w > k0);
      r1 += (x.x > k1) + (x.y > k1) + (x.z > k1) + (x.w > k1);
    }
    const bool s0 = (lane <= cur) && (r0 < 16);
    const bool s1 = (lane + 64 <= cur) && (r1 < 16);
    const u64 mlo = __ballot(s0), mhi = __ballot(s1);
    if (lane == 0) { selmask[(w * 8 + q) * 2] = mlo; selmask[(w * 8 + q) * 2 + 1] = mhi; }
    ulo |= mlo; uhi |= mhi;
  }
  if (lane == 0) { unionm[w * 2] = ulo; unionm[w * 2 + 1] = uhi; }
  __syncthreads();
  const u64 mylo = selmask[(w * 8 + qi) * 2], myhi = selmask[(w * 8 + qi) * 2 + 1];
  u64 blo = unionm[0] | unionm[2] | unionm[4] | unionm[6];
  u64 bhi = unionm[1] | unionm[3] | unionm[5] | unionm[7];
  f32x16 osel[2];
#pragma unroll
  for (int i = 0; i < 16; ++i) { osel[0][i] = 0.f; osel[1][i] = 0.f; }
  float m2 = 0.f, l2 = 0.f;
  const u16* ksel = p.h + (size_t)b * SEQ * HC + C_BSK + kv * 64;
  const u16* vsel = p.h + (size_t)b * SEQ * HC + C_BSV + kv * 64;
  int j = 0;
  blo &= blo - 1;
  for (; j >= 0; ++gt) {
    u16* sK = sbase + (gt & 1) * (128 * LDT);
    u16* sV = sK + 64 * LDT;
    tile_st(sK, kr, tid);
    tile_st(sV, vr, tid);
    __syncthreads();
    int jn = -1;
    if (blo) { jn = __builtin_ctzll(blo); blo &= blo - 1; }
    else if (bhi) { jn = 64 + __builtin_ctzll(bhi); bhi &= bhi - 1; }
    if (jn >= 0) {
      tile_ld<false>(kr, ksel + (size_t)jn * 64 * HC, HC, 64, tid);
      tile_ld<false>(vr, vsel + (size_t)jn * 64 * HC, HC, 64, tid);
    }
    const u64 wsel = j < 64 ? (ulo >> j) : (uhi >> (j - 64));
    if (wsel & 1ull) {
      const u64 msel = j < 64 ? (mylo >> j) : (myhi >> (j - 64));
      const bool mine = (msel & 1ull) != 0;
      f32x16 st[2];
      qk_tile(sK, qf, st, lane);
      add_bias(st, slope_l2, mine ? slope_l2 * (float)(j * 64 + 4 * hs - t) - m2 : NEGB);
      if (j >= cur) {
        const int d0 = t - j * 64 - 4 * hs;
#pragma unroll
        for (int kb = 0; kb < 2; ++kb)
#pragma unroll
          for (int r = 0; r < 16; ++r)
            st[kb][r] = (kb * 32 + (r & 3) + 8 * (r >> 2) <= d0) ? st[kb][r] : NEGB;
      }
      const float alpha = softmax_step(st, m2, l2);
      if (__any(alpha != 1.f)) {
#pragma unroll
        for (int i = 0; i < 16; ++i) { osel[0][i] *= alpha; osel[1][i] *= alpha; }
      }
      pv_tile(sV, st, osel, lane);
    }
    j = jn;
  }
  l2 += __shfl_xor(l2, 32);
  const float inv2 = 1.f / l2;
  const float g0 = sigmoidf_(bf2f(hrow[C_BGATE + head * 3 + 0]));
  const float g1 = sigmoidf_(bf2f(hrow[C_BGATE + head * 3 + 1])) * inv2;
  const float g2 = sigmoidf_(bf2f(hrow[C_BGATE + head * 3 + 2]));
  const u16* ow = p.owin + ((size_t)b * SEQ + t) * 512 + head * 64;
  u16* sO = reinterpret_cast<u16*>(smem + 55296) + w * (32 * LDT);
#pragma unroll
  for (int db = 0; db < 2; ++db)
#pragma unroll
    for (int q4 = 0; q4 < 4; ++q4) {
      const int d0 = db * 32 + 8 * q4 + 4 * hs;
      uint2 wv = *reinterpret_cast<const uint2*>(ow + d0);
      uint2 gv = *reinterpret_cast<const uint2*>(hrow + C_BG + head * 64 + d0);
      float v0 = (g0 * ocmp[db][4 * q4 + 0] + g1 * osel[db][4 * q4 + 0] + g2 * lo_f(wv.x)) * siluf_(lo_f(gv.x));
      float v1 = (g0 * ocmp[db][4 * q4 + 1] + g1 * osel[db][4 * q4 + 1] + g2 * hi_f(wv.x)) * siluf_(hi_f(gv.x));
      float v2 = (g0 * ocmp[db][4 * q4 + 2] + g1 * osel[db][4 * q4 + 2] + g2 * lo_f(wv.y)) * siluf_(lo_f(gv.y));
      float v3 = (g0 * ocmp[db][4 * q4 + 3] + g1 * osel[db][4 * q4 + 3] + g2 * hi_f(wv.y)) * siluf_(hi_f(gv.y));
      uint2 ov;
      ov.x = pack2(v0, v1); ov.y = pack2(v2, v3);
      *reinterpret_cast<uint2*>(sO + n * LDT + d0) = ov;
    }
  asm volatile("s_waitcnt lgkmcnt(0)" ::: "memory");
#pragma unroll
  for (int i = 0; i < 4; ++i) {
    const int row = (lane >> 3) + 8 * i, ch = lane & 7;
    const u32x4 v = *reinterpret_cast<const u32x4*>(sO + row * LDT + ch * 8);
    *reinterpret_cast<u32x4*>(p.y + ((size_t)NTOK + (size_t)b * SEQ + t0 + 8 * w + (row >> 2)) * 512 +
                              (kv * 4 + (row & 3)) * 64 + ch * 8) = v;
  }
  __syncthreads();
}

__device__ __forceinline__ void combineA_item(const Params& p, int item) {
#pragma unroll 4
  for (int j = 0; j < 8; ++j) {
    const int id = tidx() + 256 * j;
    const int tt = item * 32 + (id >> 6), c0 = (id & 63) * 8, hh = c0 >> 6;
    float l0 = p.lseA[((size_t)0 * NTOK + tt) * 8 + hh];
    float l1 = p.lseA[((size_t)1 * NTOK + tt) * 8 + hh];
    float l2 = p.lseA[((size_t)2 * NTOK + tt) * 8 + hh];
    const float mx = fmaxf(l0, fmaxf(l1, l2));
    float w0 = ex2(l0 - mx), w1 = ex2(l1 - mx), w2 = ex2(l2 - mx);
    const float inv = 1.f / (w0 + w1 + w2);
    w0 *= inv; w1 *= inv; w2 *= inv;
    uint4 a0 = *reinterpret_cast<const uint4*>(p.oA + ((size_t)0 * NTOK + tt) * 512 + c0);
    uint4 a1 = *reinterpret_cast<const uint4*>(p.oA + ((size_t)1 * NTOK + tt) * 512 + c0);
    uint4 a2 = *reinterpret_cast<const uint4*>(p.oA + ((size_t)2 * NTOK + tt) * 512 + c0);
    uint4 gv = *reinterpret_cast<const uint4*>(p.h + (size_t)tt * HC + C_AG + c0);
    uint4 o;
    o.x = pack2((w0 * lo_f(a0.x) + w1 * lo_f(a1.x) + w2 * lo_f(a2.x)) * siluf_(lo_f(gv.x)),
                (w0 * hi_f(a0.x) + w1 * hi_f(a1.x) + w2 * hi_f(a2.x)) * siluf_(hi_f(gv.x)));
    o.y = pack2((w0 * lo_f(a0.y) + w1 * lo_f(a1.y) + w2 * lo_f(a2.y)) * siluf_(lo_f(gv.y)),
                (w0 * hi_f(a0.y) + w1 * hi_f(a1.y) + w2 * hi_f(a2.y)) * siluf_(hi_f(gv.y)));
    o.z = pack2((w0 * lo_f(a0.z) + w1 * lo_f(a1.z) + w2 * lo_f(a2.z)) * siluf_(lo_f(gv.z)),
                (w0 * hi_f(a0.z) + w1 * hi_f(a1.z) + w2 * hi_f(a2.z)) * siluf_(hi_f(gv.z)));
    o.w = pack2((w0 * lo_f(a0.w) + w1 * lo_f(a1.w) + w2 * lo_f(a2.w)) * siluf_(lo_f(gv.w)),
                (w0 * hi_f(a0.w) + w1 * hi_f(a1.w) + w2 * hi_f(a2.w)) * siluf_(hi_f(gv.w)));
    *reinterpret_cast<uint4*>(p.y + (size_t)tt * 512 + c0) = o;
  }
}

__device__ __forceinline__ void phase_attn2(const Params& p, int layer, char* smem) {
  const int total = 1024 + 512;
  int* slot = reinterpret_cast<int*>(smem + SMEM_BYTES);
  unsigned* ctr = p.ctr + layer * 4 + 2;
  for (;;) {
    const int idx = next_item(ctr, slot);
    if (idx >= total) break;
    if (idx < 1024) {
      const int chunk = 255 - (idx >> 2), b = (idx >> 1) & 1, kv = idx & 1;
      nsa_item(p, b, kv, chunk, smem);
    } else {
      combineA_item(p, idx - 1024);
    }
  }
}

#define XB_TMO 128
#define XB_XCNT(j) (256 + 64 * (j))
#define XB_XSUB(j) (1280 + 64 * (j))
#define XB_XGEN(j) (2304 + 64 * (j))
#define XB_TOP 3328
#define XB_TOPGEN 3392
#define XB_SPIN_CAP (1u << 20)
__device__ __forceinline__ unsigned xb_ld(unsigned* q) { return __hip_atomic_load(q, __ATOMIC_RELAXED, __HIP_MEMORY_SCOPE_AGENT); }
__device__ __forceinline__ unsigned xb_add(unsigned* q, unsigned v) {
  return __hip_atomic_fetch_add(q, v, __ATOMIC_RELAXED, __HIP_MEMORY_SCOPE_AGENT);
}
__device__ __forceinline__ unsigned xb_xcc_id() { return (unsigned)__builtin_amdgcn_s_getreg((3 << 11) | 20) & 0xFu; }
#define XB_SPIN(cond, bar)                                                                    \
  do {                                                                                        \
    unsigned _sp = 0;                                                                         \
    while (cond) {                                                                            \
      __builtin_amdgcn_s_sleep(1);                                                            \
      if ((++_sp & 255u) == 0u) {                                                             \
        if (xb_ld(&(bar)[XB_TMO])) break;                                                     \
        if (_sp > XB_SPIN_CAP) { atomicAdd(&(bar)[XB_TMO], 1u); break; }                      \
      }                                                                                       \
    }                                                                                         \
  } while (0)
__device__ __forceinline__ void xcd_barrier(unsigned* bar, volatile unsigned* xst) {
  asm volatile("s_waitcnt vmcnt(0)" ::: "memory");
  __syncthreads();
  if (threadIdx.x == 0) {
    __builtin_amdgcn_s_waitcnt(0);
    unsigned nloc = xst[0], nx = xst[1];
    const unsigned x = xst[2];
    if (nloc == 0u) {
      const unsigned G = gridDim.x;
      unsigned sp = 0u;
      for (;;) {
        unsigned sum = 0u, cnt = 0u, mine = 0u;
#pragma unroll
        for (unsigned j = 0; j < 16; ++j) {
          const unsigned c = xb_ld(&bar[XB_XCNT(j)]);
          sum += c;
          cnt += (c > 0u) ? 1u : 0u;
          mine = (j == x) ? c : mine;
        }
        nloc = mine > 0u ? mine : 1u;
        nx = cnt > 0u ? cnt : 1u;
        if (sum == G) break;
        __builtin_amdgcn_s_sleep(1);
        if ((++sp & 255u) == 0u) {
          if (xb_ld(&bar[XB_TMO])) break;
          if (sp > XB_SPIN_CAP) { atomicAdd(&bar[XB_TMO], 1u); break; }
        }
      }
      xst[0] = nloc;
      xst[1] = nx;
    }
    const unsigned old = xb_add(&bar[XB_XSUB(x)], 1u);
    const unsigned gen = old / nloc;
    if (old + 1u == (gen + 1u) * nloc) {
      __builtin_amdgcn_fence(__ATOMIC_RELEASE, "agent");
      asm volatile("s_waitcnt vmcnt(0)" ::: "memory");
      const unsigned og = xb_add(&bar[XB_TOP], 1u);
      const unsigned tg = og / nx;
      if (og + 1u == (tg + 1u) * nx) xb_add(&bar[XB_TOPGEN], 1u);
      else XB_SPIN(xb_ld(&bar[XB_TOPGEN]) == tg, bar);
      __builtin_amdgcn_fence(__ATOMIC_ACQUIRE, "agent");
      xb_add(&bar[XB_XGEN(x)], 1u);
      asm volatile("s_waitcnt vmcnt(0)" ::: "memory");
    } else {
      XB_SPIN(xb_ld(&bar[XB_XGEN(x)]) == gen, bar);
      __builtin_amdgcn_fence(__ATOMIC_ACQUIRE, "agent");
      asm volatile("s_waitcnt vmcnt(0)" ::: "memory");
    }
  }
  __syncthreads();
}

__global__ void __launch_bounds__(256, 2) mega(Params p, int ph_lo, int ph_hi) {
  __shared__ __attribute__((aligned(16))) char smem[SMEM_BYTES + 16];
  __shared__ unsigned xst[4];
  cg::grid_group grid = cg::this_grid();
  if (ph_hi < 0) grid.sync();
  if (threadIdx.x == 0) {
    const unsigned x = xb_xcc_id();
    xst[0] = 0u;
    xst[1] = 0u;
    xst[2] = x;
    (void)xb_add(&p.xbar[XB_XCNT(x)], 1u);
  }
  for (int ph = ph_lo; ph <= ph_hi; ++ph) {
    if (ph > ph_lo) xcd_barrier(p.xbar, xst);
    if (ph == 0) {
      phase_prep(p, smem);
    } else {
      const int layer = (ph - 1) / 6, s = (ph - 1) % 6;
      switch (s) {
        case 0: phase_gemm_in(p, layer, smem); break;
        case 1: phase_attn1(p, layer, smem); break;
        case 2: phase_attn2(p, layer, smem); break;
        case 3: phase_gemm_branch(p, layer, smem); break;
        case 4: phase_gemm_out(p, layer, smem); break;
        default: phase_ln(p, layer); break;
      }
    }
  }
}

extern "C" void kernel_launch(void* const* d_in, const int* in_sizes, int n_in, void* d_out, int out_size, void* d_ws,
                              size_t ws_size, hipStream_t stream) {
  Params p{};
  p.x = (const float*)d_in[0];
  p.w_in = (const float*)d_in[1];
  p.b_in = (const float*)d_in[2];
  p.w_cmp1 = (const float*)d_in[3];
  p.w_cmp2 = (const float*)d_in[4];
  p.cmp_pos = (const float*)d_in[5];
  p.sinks = (const float*)d_in[6];
  p.w_branch = (const float*)d_in[7];
  p.w_out = (const float*)d_in[8];
  p.ln_g = (const float*)d_in[9];
  p.ln_b = (const float*)d_in[10];
  p.out = (float*)d_out;
  char* ws = (char*)d_ws;
  size_t off = 0;
  auto take = [&](size_t bytes) { char* r = ws + off; off += (bytes + 255) & ~(size_t)255; return r; };
  p.xb = (u16*)take((size_t)NTOK * DM * 2);
  p.wt_in = (u16*)take((size_t)DEPTH * HC * DM * 2);
  p.w1t = (u16*)take((size_t)DEPTH * 2 * 256 * 2048 * 2);
  p.w2t = (u16*)take((size_t)DEPTH * 2 * 64 * 256 * 2);
  p.wbt = (u16*)take((size_t)DEPTH * 3 * 1024 * 512 * 2);
  p.wot = (u16*)take((size_t)DEPTH * 1024 * 1024 * 2);
  p.bias = (float*)take((size_t)DEPTH * HC * 4);
  p.h = (u16*)take((size_t)NTOK * HC * 2);
  p.z = (float*)p.h;
  p.oA = (u16*)take((size_t)3 * NTOK * 512 * 2);
  p.merged = p.oA;
  p.lseA = (float*)take((size_t)3 * NTOK * 8 * 4);
  p.owin = (u16*)take((size_t)NTOK * 512 * 2);
  p.y = (u16*)take((size_t)3 * NTOK * 512 * 2);
  p.kcmp = (u16*)take((size_t)4 * 512 * 64 * 2);
  p.vcmp = (u16*)take((size_t)4 * 512 * 64 * 2);
  p.ctr = (unsigned*)take(1024);
  p.xbar = (unsigned*)take(16384);

  static int grid_blocks = 0;
  if (!grid_blocks) {
    int dev = 0, cus = 0, per_cu = 0;
    hipGetDevice(&dev);
    hipDeviceGetAttribute(&cus, hipDeviceAttributeMultiprocessorCount, dev);
    hipOccupancyMaxActiveBlocksPerMultiprocessor(&per_cu, mega, 256, 0);
    if (per_cu < 1) per_cu = 1;
    if (per_cu > 2) per_cu = 2;
    grid_blocks = cus * per_cu;
  }
  hipMemsetAsync(p.xbar, 0, 16384, stream);
  int lo = 0, hi = 6 * DEPTH;
  void* args[] = {&p, &lo, &hi};
  hipError_t e = hipLaunchCooperativeKernel((void*)mega, dim3(grid_blocks), dim3(256), args, 0, stream);
  if (e != hipSuccess) fprintf(stderr, "cooperative launch failed: %s (grid %d)\n", hipGetErrorString(e), grid_blocks);
}
```

```cpp
#include <hip/hip_runtime.h>
#include <hip/hip_cooperative_groups.h>
#include <cstdio>
#include <cstdint>
namespace cg = cooperative_groups;

typedef unsigned short u16;
typedef unsigned long long u64;
typedef __attribute__((ext_vector_type(8))) __bf16 bf16x8;
typedef __attribute__((ext_vector_type(2))) __bf16 bf16x2;
typedef __attribute__((ext_vector_type(4))) short s16x4;
typedef __attribute__((ext_vector_type(8))) short s16x8;
typedef __attribute__((ext_vector_type(2))) float f32x2;
typedef __attribute__((ext_vector_type(4))) float f32x4;
typedef __attribute__((ext_vector_type(16))) float f32x16;
typedef __attribute__((ext_vector_type(4))) unsigned u32x4;
typedef __attribute__((ext_vector_type(2))) unsigned u32x2;

constexpr int SEQ = 8192, NTOK = 16384, DM = 1024, DEPTH = 4;
constexpr int HC = 11392;
constexpr int C_AQ = 0, C_AK = 1536, C_AV = 3072, C_AG = 4608, C_BQ = 5120, C_BCK = 5632, C_BCV = 5760,
              C_BSK = 5888, C_BSV = 6016, C_BWK = 6144, C_BWV = 6272, C_BG = 6400, C_CQ = 6912, C_CK = 7424,
              C_CV = 7552, C_CG = 7680, C_MG = 8192, C_BGATE = 11264;
constexpr int IN_COLS = 11288;
constexpr float LOG2E = 1.4426950408889634f;
constexpr float C1 = 0.125f * LOG2E;
constexpr float NEGB = -1e30f;
constexpr float DN_ALPHA = 1.681792830507429f;
constexpr int LDT = 72;
constexpr int SMEM_BYTES = 73728;
constexpr int IMPS = 132;

struct Params {
  const float *x, *w_in, *b_in, *w_cmp1, *w_cmp2, *cmp_pos, *sinks, *w_branch, *w_out, *ln_g, *ln_b;
  float* out;
  u16 *xb, *wt_in, *w1t, *w2t, *wbt, *wot, *h, *oA, *owin, *y, *merged, *kcmp, *vcmp;
  float *bias, *lseA, *z;
  unsigned* ctr;
  unsigned* xbar;
  unsigned* lnpart;
};

__device__ __forceinline__ int tidx() {
  int t = threadIdx.x;
  asm volatile("" : "+v"(t));
  return t;
}
__device__ __forceinline__ float bf2f(u16 v) { return __uint_as_float(((unsigned)v) << 16); }
__device__ __forceinline__ unsigned pack2(float a, float b) {
  f32x2 f = {a, b};
  bf16x2 c = __builtin_convertvector(f, bf16x2);
  return __builtin_bit_cast(unsigned, c);
}
__device__ __forceinline__ u16 f2bf(float a) { return (u16)(pack2(a, 0.f) & 0xffffu); }
__device__ __forceinline__ float lo_f(unsigned v) { return __uint_as_float(v << 16); }
__device__ __forceinline__ float hi_f(unsigned v) { return __uint_as_float(v & 0xffff0000u); }
__device__ __forceinline__ float ex2(float x) { return __builtin_amdgcn_exp2f(x); }
__device__ __forceinline__ float sigmoidf_(float x) { return __builtin_amdgcn_rcpf(1.f + __expf(-x)); }
__device__ __forceinline__ float siluf_(float x) { return x * __builtin_amdgcn_rcpf(1.f + __expf(-x)); }
__device__ __forceinline__ float gelu_tanh(float x) {
  float u = 0.7978845608028654f * (x + 0.044715f * x * x * x);
  float t = 1.f - 2.f / (__expf(2.f * u) + 1.f);
  return 0.5f * x * (1.f + t);
}
__device__ __forceinline__ bf16x8 ld_frag(const u16* p) { return *reinterpret_cast<const bf16x8*>(p); }
__device__ __forceinline__ bf16x8 tr_frag(const u16* p0, const u16* p1) {
  s16x4 lo = __builtin_amdgcn_ds_read_tr16_b64_v4i16((__attribute__((address_space(3))) s16x4*)(p0));
  s16x4 hi = __builtin_amdgcn_ds_read_tr16_b64_v4i16((__attribute__((address_space(3))) s16x4*)(p1));
  s16x8 r = __builtin_shufflevector(lo, hi, 0, 1, 2, 3, 4, 5, 6, 7);
  return __builtin_bit_cast(bf16x8, r);
}
__device__ __forceinline__ f32x4 mfma16(bf16x8 a, bf16x8 b, f32x4 c) {
  return __builtin_amdgcn_mfma_f32_16x16x32_bf16(a, b, c, 0, 0, 0);
}
__device__ __forceinline__ f32x16 mfma32(bf16x8 a, bf16x8 b, f32x16 c) {
  return __builtin_amdgcn_mfma_f32_32x32x16_bf16(a, b, c, 0, 0, 0);
}


__device__ __forceinline__ int next_item(unsigned* ctr, int* slot) {
  __syncthreads();
  if (tidx() == 0) *slot = (int)atomicAdd(ctr, 1u);
  __syncthreads();
  return *slot;
}

__device__ __forceinline__ int src_col_in(int n) {
  return n < 6912 ? n : (n < 11264 ? n + 24 : (n < 11288 ? n - 11264 + 6912 : -1));
}
__device__ __forceinline__ void transpose_tile(const float* __restrict__ src, int Nsrc, u16* __restrict__ dst, int K, int n0, int k0,
                               bool perm, float* tile) {
  const int tx = tidx() & 63, ty = tidx() >> 6;
  const int n = n0 + tx;
  const int sc = perm ? src_col_in(n) : n;
  float v[32];
#pragma unroll
  for (int i = 0; i < 32; ++i) {
    int kk = ty + 4 * i;
    v[i] = sc >= 0 ? src[(size_t)(k0 + kk) * Nsrc + sc] : 0.f;
  }
#pragma unroll
  for (int i = 0; i < 32; ++i) tile[(ty + 4 * i) * 65 + tx] = v[i];
  __syncthreads();
#pragma unroll
  for (int j = 0; j < 4; ++j) {
    int id = tidx() + 256 * j;
    int nn = id >> 4, kc = id & 15;
    uint4 o;
    o.x = pack2(tile[(kc * 8 + 0) * 65 + nn], tile[(kc * 8 + 1) * 65 + nn]);
    o.y = pack2(tile[(kc * 8 + 2) * 65 + nn], tile[(kc * 8 + 3) * 65 + nn]);
    o.z = pack2(tile[(kc * 8 + 4) * 65 + nn], tile[(kc * 8 + 5) * 65 + nn]);
    o.w = pack2(tile[(kc * 8 + 6) * 65 + nn], tile[(kc * 8 + 7) * 65 + nn]);
    *reinterpret_cast<uint4*>(dst + (size_t)(n0 + nn) * K + k0 + kc * 8) = o;
  }
  __syncthreads();
}

__device__ __forceinline__ void phase_prep(const Params& p, char* smem) {
  float* tile = reinterpret_cast<float*>(smem);
  const int NT_IN = HC / 64;
  const int n_in = DEPTH * NT_IN * 8;
  const int n_c1 = 8 * 4 * 16;
  const int n_c2 = 8 * 1 * 2;
  const int n_br = 12 * 16 * 4;
  const int n_wo = 4 * 16 * 8;
  const int total = n_in + n_c1 + n_c2 + n_br + n_wo;
  for (int idx = blockIdx.x; idx < total; idx += gridDim.x) {
    int i = idx;
    if (i < n_in) {
      int l = i / (NT_IN * 8), r = i % (NT_IN * 8);
      int nt = r / 8, kt = r % 8;
      transpose_tile(p.w_in + (size_t)l * DM * IN_COLS, IN_COLS, p.wt_in + (size_t)l * HC * DM, DM, nt * 64, kt * 128,
                     true, tile);
      continue;
    }
    i -= n_in;
    if (i < n_c1) {
      int mtx = i / 64, r = i % 64;
      int nt = r / 16, kt = r % 16;
      transpose_tile(p.w_cmp1 + (size_t)mtx * 2048 * 256, 256, p.w1t + (size_t)mtx * 256 * 2048, 2048, nt * 64, kt * 128,
                     false, tile);
      continue;
    }
    i -= n_c1;
    if (i < n_c2) {
      int mtx = i / 2, kt = i % 2;
      transpose_tile(p.w_cmp2 + (size_t)mtx * 256 * 64, 64, p.w2t + (size_t)mtx * 64 * 256, 256, 0, kt * 128, false, tile);
      continue;
    }
    i -= n_c2;
    if (i < n_br) {
      int mtx = i / 64, r = i % 64;
      int nt = r / 4, kt = r % 4;
      transpose_tile(p.w_branch + (size_t)mtx * 512 * 1024, 1024, p.wbt + (size_t)mtx * 1024 * 512, 512, nt * 64, kt * 128,
                     false, tile);
      continue;
    }
    i -= n_br;
    {
      int mtx = i / 128, r = i % 128;
      int nt = r / 8, kt = r % 8;
      transpose_tile(p.w_out + (size_t)mtx * 1024 * 1024, 1024, p.wot + (size_t)mtx * 1024 * 1024, 1024, nt * 64, kt * 128,
                     false, tile);
    }
  }
  if (blockIdx.x == 0) {
#pragma unroll
    for (int q = 0; q < 5; ++q) p.ctr[q * 256 + tidx()] = 0u;
  }
  const size_t nchunk = (size_t)NTOK * DM / 8;
  for (size_t c = (size_t)blockIdx.x * 256 + tidx(); c < nchunk; c += (size_t)gridDim.x * 256) {
    const float4* s = reinterpret_cast<const float4*>(p.x + c * 8);
    float4 a = s[0], b = s[1];
    uint4 o;
    o.x = pack2(a.x, a.y); o.y = pack2(a.z, a.w); o.z = pack2(b.x, b.y); o.w = pack2(b.z, b.w);
    *reinterpret_cast<uint4*>(p.xb + c * 8) = o;
  }
  for (int c = blockIdx.x * 256 + tidx(); c < DEPTH * HC; c += gridDim.x * 256) {
    int l = c / HC, n = c % HC;
    int sc = src_col_in(n);
    p.bias[c] = sc >= 0 ? p.b_in[(size_t)l * IN_COLS + sc] : 0.f;
  }
}

constexpr int GLD = 64;
constexpr int GSTAGE = 256 * GLD;
template <int NN>
__device__ __forceinline__ void gemm_mainloop(const u16* __restrict__ A, int lda, const u16* __restrict__ B, int ldb,
                                              int K, f32x4 (&acc)[4][NN], u16* smem16) {
  const int tid = tidx(), lane = tid & 63, w = tid >> 6, wm = w >> 1, wn = w & 1;
  const int lr = tid >> 3, lc = (tid & 7) * 8;
  const int wofs = lr * GLD + (((tid & 7) ^ (lr & 7)) * 8);
  const int rph0 = (((lane >> 4) ^ (lane & 7)) * 8);
  u32x4 ra[4], rb[NN];
  const u16* Ap = A + (size_t)lr * lda + lc;
  const u16* Bp = B + (size_t)lr * ldb + lc;
#pragma unroll
  for (int i = 0; i < 4; ++i) ra[i] = *reinterpret_cast<const u32x4*>(Ap + (size_t)(32 * i) * lda);
#pragma unroll
  for (int i = 0; i < NN; ++i) rb[i] = *reinterpret_cast<const u32x4*>(Bp + (size_t)(32 * i) * ldb);
  const int nk = K >> 6;
  {
    u16* sA = smem16;
    u16* sB = smem16 + 128 * GLD;
#pragma unroll
    for (int i = 0; i < 4; ++i) *reinterpret_cast<u32x4*>(sA + 32 * i * GLD + wofs) = ra[i];
#pragma unroll
    for (int i = 0; i < NN; ++i) *reinterpret_cast<u32x4*>(sB + 32 * i * GLD + wofs) = rb[i];
  }
  if (nk > 1) {
#pragma unroll
    for (int i = 0; i < 4; ++i) ra[i] = *reinterpret_cast<const u32x4*>(Ap + (size_t)(32 * i) * lda + 64);
#pragma unroll
    for (int i = 0; i < NN; ++i) rb[i] = *reinterpret_cast<const u32x4*>(Bp + (size_t)(32 * i) * ldb + 64);
  }
  __syncthreads();
  for (int kt = 0; kt < nk; ++kt) {
    const u16* sA = smem16 + (kt & 1) * GSTAGE;
    const u16* sB = sA + 128 * GLD;
#pragma unroll
    for (int kk = 0; kk < 2; ++kk) {
      const int ph = rph0 ^ (kk * 32);
      bf16x8 a[4], b[NN];
#pragma unroll
      for (int m = 0; m < 4; ++m) a[m] = ld_frag(sA + (wm * 64 + m * 16 + (lane & 15)) * GLD + ph);
#pragma unroll
      for (int n = 0; n < NN; ++n) b[n] = ld_frag(sB + (wn * 16 * NN + n * 16 + (lane & 15)) * GLD + ph);
#pragma unroll
      for (int m = 0; m < 4; ++m)
#pragma unroll
        for (int n = 0; n < NN; ++n) acc[m][n] = mfma16(b[n], a[m], acc[m][n]);
    }
    if (kt + 1 < nk) {
      u16* dA = smem16 + ((kt + 1) & 1) * GSTAGE;
      u16* dB = dA + 128 * GLD;
#pragma unroll
      for (int i = 0; i < 4; ++i) *reinterpret_cast<u32x4*>(dA + 32 * i * GLD + wofs) = ra[i];
#pragma unroll
      for (int i = 0; i < NN; ++i) *reinterpret_cast<u32x4*>(dB + 32 * i * GLD + wofs) = rb[i];
    }
    if (kt + 2 < nk) {
      const int k0 = (kt + 2) << 6;
#pragma unroll
      for (int i = 0; i < 4; ++i) ra[i] = *reinterpret_cast<const u32x4*>(Ap + (size_t)(32 * i) * lda + k0);
#pragma unroll
      for (int i = 0; i < NN; ++i) rb[i] = *reinterpret_cast<const u32x4*>(Bp + (size_t)(32 * i) * ldb + k0);
    }
    __syncthreads();
  }
}

constexpr int WSTAGE = 384 * 32;
__device__ __forceinline__ void gemm_mainloop_wide(const u16* __restrict__ A, int lda, const u16* __restrict__ B,
                                                   int ldb, int K, f32x4 (&acc)[4][8], u16* smem16) {
  const int tid = tidx(), lane = tid & 63, w = tid >> 6, wm = w >> 1, wn = w & 1;
  const int lr = tid >> 2, lc = (tid & 3) * 8;
  const int wofs = lr * 32 + (((tid & 3) ^ ((4 - ((lr >> 2) & 3)) & 3)) * 8);
  const int rofs = (lane & 15) * 32 + (((lane >> 4) ^ ((4 - ((lane & 15) >> 2)) & 3)) * 8);
  u32x4 ra[2], rb[4];
  const u16* Ap = A + (size_t)lr * lda + lc;
  const u16* Bp = B + (size_t)lr * ldb + lc;
#pragma unroll
  for (int i = 0; i < 2; ++i) ra[i] = *reinterpret_cast<const u32x4*>(Ap + (size_t)(64 * i) * lda);
#pragma unroll
  for (int i = 0; i < 4; ++i) rb[i] = *reinterpret_cast<const u32x4*>(Bp + (size_t)(64 * i) * ldb);
  const int nk = K >> 5;
#pragma unroll
  for (int i = 0; i < 2; ++i) *reinterpret_cast<u32x4*>(smem16 + 64 * i * 32 + wofs) = ra[i];
#pragma unroll
  for (int i = 0; i < 4; ++i) *reinterpret_cast<u32x4*>(smem16 + (128 + 64 * i) * 32 + wofs) = rb[i];
#pragma unroll
  for (int i = 0; i < 2; ++i) ra[i] = *reinterpret_cast<const u32x4*>(Ap + (size_t)(64 * i) * lda + 32);
#pragma unroll
  for (int i = 0; i < 4; ++i) rb[i] = *reinterpret_cast<const u32x4*>(Bp + (size_t)(64 * i) * ldb + 32);
  __syncthreads();
  for (int kt = 0; kt < nk; ++kt) {
    const u16* sA = smem16 + (kt & 1) * WSTAGE;
    const u16* sB = sA + 128 * 32;
    bf16x8 a[4];
#pragma unroll
    for (int m = 0; m < 4; ++m) a[m] = ld_frag(sA + (wm * 64 + m * 16) * 32 + rofs);
#pragma unroll
    for (int nh = 0; nh < 2; ++nh) {
      bf16x8 b[4];
#pragma unroll
      for (int n = 0; n < 4; ++n) b[n] = ld_frag(sB + (wn * 128 + nh * 64 + n * 16) * 32 + rofs);
#pragma unroll
      for (int m = 0; m < 4; ++m)
#pragma unroll
        for (int n = 0; n < 4; ++n) acc[m][nh * 4 + n] = mfma16(b[n], a[m], acc[m][nh * 4 + n]);
    }
    if (kt + 1 < nk) {
      u16* d = smem16 + ((kt + 1) & 1) * WSTAGE;
#pragma unroll
      for (int i = 0; i < 2; ++i) *reinterpret_cast<u32x4*>(d + 64 * i * 32 + wofs) = ra[i];
#pragma unroll
      for (int i = 0; i < 4; ++i) *reinterpret_cast<u32x4*>(d + (128 + 64 * i) * 32 + wofs) = rb[i];
    }
    {
      const int k0 = ((kt + 2 < nk) ? kt + 2 : nk - 1) << 5;
#pragma unroll
      for (int i = 0; i < 2; ++i) ra[i] = *reinterpret_cast<const u32x4*>(Ap + (size_t)(64 * i) * lda + k0);
#pragma unroll
      for (int i = 0; i < 4; ++i) rb[i] = *reinterpret_cast<const u32x4*>(Bp + (size_t)(64 * i) * ldb + k0);
    }
    __syncthreads();
  }
}

constexpr int LDC = 136;
constexpr int LDCW = 264;
__device__ __forceinline__ void phase_gemm_in(const Params& p, int layer, char* smem) {
  u16* s16 = reinterpret_cast<u16*>(smem);
  const int tid = tidx(), lane = tid & 63, w = tid >> 6, wm = w >> 1, wn = w & 1;
  const u16* W = p.wt_in + (size_t)layer * HC * DM;
  const float* bias = p.bias + (size_t)layer * HC;
  const int xcd = blockIdx.x & 7, loc = blockIdx.x >> 3, nxl = gridDim.x >> 3;
  const int per_st = (loc < 64 && loc < nxl) ? (64 - loc + nxl - 1) / nxl : 0;
  const int n_main = ((88 - xcd + 7) / 8) * per_st;
  for (int u = 0; u < n_main; ++u) {
    const int st = xcd + 8 * (u / per_st), j = loc + (u % per_st) * nxl;
    const int mt = (st / 11) * 16 + (j & 15);
    const int nt = (st % 11) * 4 + (j >> 4);
    const int m0 = mt * 128, n0 = nt * 256;
    f32x4 acc[4][8];
#pragma unroll
    for (int m = 0; m < 4; ++m)
#pragma unroll
      for (int n = 0; n < 8; ++n) acc[m][n] = (f32x4){0.f, 0.f, 0.f, 0.f};
    gemm_mainloop_wide(p.xb + (size_t)m0 * DM, DM, W + (size_t)n0 * DM, DM, DM, acc, s16);
#pragma unroll
    for (int n = 0; n < 8; ++n) {
      const int col = wn * 128 + n * 16 + (lane >> 4) * 4;
      const float4 bv = *reinterpret_cast<const float4*>(bias + n0 + col);
#pragma unroll
      for (int m = 0; m < 4; ++m) {
        const int row = wm * 64 + m * 16 + (lane & 15);
        uint2 pk;
        pk.x = pack2(acc[m][n][0] + bv.x, acc[m][n][1] + bv.y);
        pk.y = pack2(acc[m][n][2] + bv.z, acc[m][n][3] + bv.w);
        *reinterpret_cast<uint2*>(s16 + row * LDCW + col) = pk;
      }
    }
    __syncthreads();
#pragma unroll
    for (int i = 0; i < 16; ++i) {
      const int id = tid + 256 * i;
      const int row = id >> 5, ch = id & 31;
      u32x4 v = *reinterpret_cast<const u32x4*>(s16 + row * LDCW + ch * 8);
      *reinterpret_cast<u32x4*>(p.h + (size_t)(m0 + row) * HC + n0 + ch * 8) = v;
    }
    __syncthreads();
  }
}

__device__ __forceinline__ void gemm_in_tail_item(const Params& p, int layer, int mt, char* smem) {
  u16* s16 = reinterpret_cast<u16*>(smem);
  const int tid = tidx(), lane = tid & 63, w = tid >> 6, wm = w >> 1, wn = w & 1;
  const u16* W = p.wt_in + (size_t)layer * HC * DM;
  const float* bias = p.bias + (size_t)layer * HC;
  const int m0 = mt * 128, n0 = C_BGATE;
  f32x4 acc[4][2];
#pragma unroll
  for (int m = 0; m < 4; ++m)
#pragma unroll
    for (int n = 0; n < 2; ++n) acc[m][n] = (f32x4){0.f, 0.f, 0.f, 0.f};
  gemm_mainloop<2>(p.xb + (size_t)m0 * DM, DM, W + (size_t)n0 * DM, DM, DM, acc, s16);
#pragma unroll
  for (int n = 0; n < 2; ++n) {
    const int col = n0 + wn * 32 + n * 16 + (lane >> 4) * 4;
    const float4 bv = *reinterpret_cast<const float4*>(bias + col);
#pragma unroll
    for (int m = 0; m < 4; ++m) {
      const int row = m0 + wm * 64 + m * 16 + (lane & 15);
      uint2 pk;
      pk.x = pack2(acc[m][n][0] + bv.x, acc[m][n][1] + bv.y);
      pk.y = pack2(acc[m][n][2] + bv.z, acc[m][n][3] + bv.w);
      *reinterpret_cast<uint2*>(p.h + (size_t)row * HC + col) = pk;
    }
  }
}

__device__ __forceinline__ void phase_gemm_branch(const Params& p, int layer, char* smem) {
  u16* s16 = reinterpret_cast<u16*>(smem);
  const int tid = tidx(), lane = tid & 63, w = tid >> 6, wm = w >> 1, wn = w & 1;
  const int xcd = blockIdx.x & 7, loc = blockIdx.x >> 3, nxl = gridDim.x >> 3;
  const int per_st = (loc < 64 && loc < nxl) ? (64 - loc + nxl - 1) / nxl : 0;
  for (int u = 0; u < per_st; ++u) {
    const int j = loc + u * nxl;
    const int mt = xcd * 16 + (j & 15), nt = j >> 4;
    const int m0 = mt * 128, n0 = nt * 256;
    f32x4 acc[4][8];
#pragma unroll
    for (int m = 0; m < 4; ++m)
#pragma unroll
      for (int n = 0; n < 8; ++n) acc[m][n] = (f32x4){0.f, 0.f, 0.f, 0.f};
    auto stage_gate = [&](int gb) {
#pragma unroll 1
      for (int hb = 0; hb < 2; ++hb) {
        u32x4 v[8];
#pragma unroll
        for (int i = 0; i < 8; ++i) {
          const int id = tid + 256 * (hb * 8 + i);
          v[i] = *reinterpret_cast<const u32x4*>(p.h + (size_t)(m0 + (id >> 5)) * HC + C_MG + gb * 1024 + n0 + (id & 31) * 8);
        }
#pragma unroll
        for (int i = 0; i < 8; ++i) {
          const int id = tid + 256 * (hb * 8 + i);
          *reinterpret_cast<u32x4*>(s16 + (id >> 5) * LDCW + (id & 31) * 8) = v[i];
        }
      }
    };
#pragma unroll 1
    for (int br = 0; br < 3; ++br) {
      const u16* A = p.y + ((size_t)br * NTOK + m0) * 512;
      const u16* B = p.wbt + ((size_t)(layer * 3 + br) * 1024 + n0) * 512;
      gemm_mainloop_wide(A, 512, B, 512, 512, acc, s16);
      stage_gate(br);
      __syncthreads();
#pragma unroll
      for (int n = 0; n < 8; ++n) {
        const int col = wn * 128 + n * 16 + (lane >> 4) * 4;
#pragma unroll
        for (int m = 0; m < 4; ++m) {
          const int row = wm * 64 + m * 16 + (lane & 15);
          const uint2 gv = *reinterpret_cast<const uint2*>(s16 + row * LDCW + col);
          acc[m][n][0] *= sigmoidf_(lo_f(gv.x));
          acc[m][n][1] *= sigmoidf_(hi_f(gv.x));
          acc[m][n][2] *= sigmoidf_(lo_f(gv.y));
          acc[m][n][3] *= sigmoidf_(hi_f(gv.y));
        }
      }
      __syncthreads();
      if (br < 2) {
        stage_gate(br + 1);
        __syncthreads();
#pragma unroll
        for (int n = 0; n < 8; ++n) {
          const int col = wn * 128 + n * 16 + (lane >> 4) * 4;
#pragma unroll
          for (int m = 0; m < 4; ++m) {
            const int row = wm * 64 + m * 16 + (lane & 15);
            const uint2 gv = *reinterpret_cast<const uint2*>(s16 + row * LDCW + col);
            acc[m][n][0] *= 1.f + __expf(-lo_f(gv.x));
            acc[m][n][1] *= 1.f + __expf(-hi_f(gv.x));
            acc[m][n][2] *= 1.f + __expf(-lo_f(gv.y));
            acc[m][n][3] *= 1.f + __expf(-hi_f(gv.y));
          }
        }
        __syncthreads();
      }
    }
#pragma unroll
    for (int n = 0; n < 8; ++n) {
      const int col = wn * 128 + n * 16 + (lane >> 4) * 4;
#pragma unroll
      for (int m = 0; m < 4; ++m) {
        const int row = wm * 64 + m * 16 + (lane & 15);
        uint2 pk;
        pk.x = pack2(acc[m][n][0], acc[m][n][1]);
        pk.y = pack2(acc[m][n][2], acc[m][n][3]);
        *reinterpret_cast<uint2*>(s16 + row * LDCW + col) = pk;
      }
    }
    __syncthreads();
#pragma unroll
    for (int i = 0; i < 16; ++i) {
      const int id = tid + 256 * i;
      const int row = id >> 5, ch = id & 31;
      const u32x4 v = *reinterpret_cast<const u32x4*>(s16 + row * LDCW + ch * 8);
      *reinterpret_cast<u32x4*>(p.merged + (size_t)(m0 + row) * DM + n0 + ch * 8) = v;
    }
    __syncthreads();
  }
}

__device__ __forceinline__ void phase_gemm_out(const Params& p, int layer, char* smem) {
  u16* s16 = reinterpret_cast<u16*>(smem);
  const int tid = tidx(), lane = tid & 63, w = tid >> 6, wm = w >> 1, wn = w & 1;
  const float* xres = layer == 0 ? p.x : p.out;
  const int xcd = blockIdx.x & 7, loc = blockIdx.x >> 3, nxl = gridDim.x >> 3;
  const int per_st = (loc < 64 && loc < nxl) ? (64 - loc + nxl - 1) / nxl : 0;
  for (int u = 0; u < per_st; ++u) {
    const int j = loc + u * nxl;
    const int mt = xcd * 16 + (j & 15), nt = j >> 4;
    const int m0 = mt * 128, n0 = nt * 256;
    f32x4 acc[4][8];
#pragma unroll
    for (int m = 0; m < 4; ++m)
#pragma unroll
      for (int n = 0; n < 8; ++n) acc[m][n] = (f32x4){0.f, 0.f, 0.f, 0.f};
    gemm_mainloop_wide(p.merged + (size_t)m0 * DM, DM, p.wot + ((size_t)layer * 1024 + n0) * 1024, 1024, 1024, acc, s16);
    const bool fused = (gridDim.x == 512);
    float* sF = reinterpret_cast<float*>(smem);
    float* sStat = reinterpret_cast<float*>(smem + 66560);
    float* sQ = reinterpret_cast<float*>(smem + 67584);
    unsigned* part = p.lnpart + ((size_t)(layer * 128 + mt) * 4) * 256;
    const float* gam = p.ln_g + (size_t)layer * DM + n0;
    const float* bet = p.ln_b + (size_t)layer * DM + n0;
#pragma unroll 1
    for (int half = 0; half < 2; ++half) {
      if (wm == half) {
#pragma unroll
        for (int n = 0; n < 8; ++n) {
          const int col = wn * 128 + n * 16 + (lane >> 4) * 4;
#pragma unroll
          for (int m = 0; m < 4; ++m) {
            const int row = m * 16 + (lane & 15);
            *reinterpret_cast<f32x4*>(sF + row * 260 + col) = acc[m][n];
          }
        }
      }
      __syncthreads();
#pragma unroll
      for (int i = 0; i < 16; ++i) {
        const int id = tid + 256 * i;
        const int row = id >> 6, c4 = (id & 63) * 4;
        const f32x4 a = *reinterpret_cast<const f32x4*>(sF + row * 260 + c4);
        const size_t g = (size_t)(m0 + half * 64 + row) * DM + n0 + c4;
        const f32x4 xv = *reinterpret_cast<const f32x4*>(xres + g);
        f32x4 o;
        o.x = DN_ALPHA * xv.x + a.x;
        o.y = DN_ALPHA * xv.y + a.y;
        o.z = DN_ALPHA * xv.z + a.z;
        o.w = DN_ALPHA * xv.w + a.w;
        if (fused) *reinterpret_cast<f32x4*>(sF + row * 260 + c4) = o;
        else *reinterpret_cast<f32x4*>(p.z + g) = o;
      }
      __syncthreads();
      if (fused) {
        {
          const int r = tid & 63, qd = tid >> 6;
          float s1 = 0.f, s2 = 0.f;
#pragma unroll 4
          for (int k = 0; k < 16; ++k) {
            const f32x4 v = *reinterpret_cast<const f32x4*>(sF + r * 260 + qd * 64 + k * 4);
            s1 += v.x + v.y + v.z + v.w;
            s2 += v.x * v.x + v.y * v.y + v.z * v.z + v.w * v.w;
          }
          sQ[(qd * 64 + r) * 2] = s1;
          sQ[(qd * 64 + r) * 2 + 1] = s2;
        }
        __syncthreads();
        unsigned* cnt = p.ctr + 256 + ((layer * 128 + mt) * 2 + half);
        if (tid < 64) {
          const float s1 = sQ[tid * 2] + sQ[(64 + tid) * 2] + sQ[(128 + tid) * 2] + sQ[(192 + tid) * 2];
          const float s2 = sQ[tid * 2 + 1] + sQ[(64 + tid) * 2 + 1] + sQ[(128 + tid) * 2 + 1] + sQ[(192 + tid) * 2 + 1];
          unsigned* dst = part + nt * 256 + (half * 64 + tid) * 2;
          __hip_atomic_store(dst, __float_as_uint(s1), __ATOMIC_RELAXED, __HIP_MEMORY_SCOPE_AGENT);
          __hip_atomic_store(dst + 1, __float_as_uint(s2), __ATOMIC_RELAXED, __HIP_MEMORY_SCOPE_AGENT);
        }
        asm volatile("s_waitcnt vmcnt(0)" ::: "memory");
        __syncthreads();
        if (tid == 0) {
          __hip_atomic_fetch_add(cnt, 1u, __ATOMIC_RELAXED, __HIP_MEMORY_SCOPE_AGENT);
          unsigned sp = 0u;
          while (__hip_atomic_load(cnt, __ATOMIC_RELAXED, __HIP_MEMORY_SCOPE_AGENT) < 4u) {
            __builtin_amdgcn_s_sleep(1);
            if (++sp > (1u << 22)) break;
          }
        }
        __syncthreads();
        if (tid < 64) {
          float s1 = 0.f, s2 = 0.f;
#pragma unroll
          for (int q = 0; q < 4; ++q) {
            const unsigned* sp_ = part + q * 256 + (half * 64 + tid) * 2;
            s1 += __uint_as_float(__hip_atomic_load(const_cast<unsigned*>(sp_), __ATOMIC_RELAXED, __HIP_MEMORY_SCOPE_AGENT));
            s2 += __uint_as_float(__hip_atomic_load(const_cast<unsigned*>(sp_) + 1, __ATOMIC_RELAXED, __HIP_MEMORY_SCOPE_AGENT));
          }
          const float mu = s1 * (1.f / DM);
          const float var = fmaxf(s2 * (1.f / DM) - mu * mu, 0.f);
          sStat[tid * 2] = mu;
          sStat[tid * 2 + 1] = rsqrtf(var + 1e-5f);
        }
        __syncthreads();
#pragma unroll 4
        for (int i = 0; i < 16; ++i) {
          const int id = tid + 256 * i;
          const int row = id >> 6, c4 = (id & 63) * 4;
          const size_t g = (size_t)(m0 + half * 64 + row) * DM + n0 + c4;
          const f32x4 zv = *reinterpret_cast<const f32x4*>(sF + row * 260 + c4);
          const f32x4 gg = *reinterpret_cast<const f32x4*>(gam + c4);
          const f32x4 be = *reinterpret_cast<const f32x4*>(bet + c4);
          const float mu = sStat[row * 2], rs = sStat[row * 2 + 1];
          f32x4 o;
          o.x = (zv.x - mu) * rs * gg.x + be.x;
          o.y = (zv.y - mu) * rs * gg.y + be.y;
          o.z = (zv.z - mu) * rs * gg.z + be.z;
          o.w = (zv.w - mu) * rs * gg.w + be.w;
          *reinterpret_cast<f32x4*>(p.out + g) = o;
          if (layer < DEPTH - 1) {
            uint2 ob;
            ob.x = pack2(o.x, o.y); ob.y = pack2(o.z, o.w);
            *reinterpret_cast<uint2*>(p.xb + g) = ob;
          }
        }
        __syncthreads();
      }
    }
  }
}

__device__ __forceinline__ void phase_ln(const Params& p, int layer) {
  const int lane = tidx() & 63, w = tidx() >> 6;
  const float* g = p.ln_g + (size_t)layer * DM;
  const float* bb = p.ln_b + (size_t)layer * DM;
  for (int idx = blockIdx.x; idx < NTOK / 8; idx += gridDim.x) {
    float4 v[2][4];
#pragma unroll
    for (int r = 0; r < 2; ++r) {
      const float* zr = p.z + (size_t)(idx * 8 + w * 2 + r) * DM;
#pragma unroll
      for (int i = 0; i < 4; ++i) v[r][i] = *reinterpret_cast<const float4*>(zr + lane * 4 + 256 * i);
    }
#pragma unroll
    for (int r = 0; r < 2; ++r) {
      const int row = idx * 8 + w * 2 + r;
      float s = 0.f;
#pragma unroll
      for (int i = 0; i < 4; ++i) s += v[r][i].x + v[r][i].y + v[r][i].z + v[r][i].w;
#pragma unroll
      for (int o = 32; o >= 1; o >>= 1) s += __shfl_xor(s, o);
      const float mu = s * (1.f / DM);
      float q = 0.f;
#pragma unroll
      for (int i = 0; i < 4; ++i) {
        float a = v[r][i].x - mu, b = v[r][i].y - mu, c = v[r][i].z - mu, d = v[r][i].w - mu;
        q += a * a + b * b + c * c + d * d;
      }
#pragma unroll
      for (int o = 32; o >= 1; o >>= 1) q += __shfl_xor(q, o);
      const float rs = rsqrtf(q * (1.f / DM) + 1e-5f);
#pragma unroll
      for (int i = 0; i < 4; ++i) {
        const int c = lane * 4 + 256 * i;
        float4 gg = *reinterpret_cast<const float4*>(g + c);
        float4 be = *reinterpret_cast<const float4*>(bb + c);
        float4 o;
        o.x = (v[r][i].x - mu) * rs * gg.x + be.x;
        o.y = (v[r][i].y - mu) * rs * gg.y + be.y;
        o.z = (v[r][i].z - mu) * rs * gg.z + be.z;
        o.w = (v[r][i].w - mu) * rs * gg.w + be.w;
        *reinterpret_cast<float4*>(p.out + (size_t)row * DM + c) = o;
        if (layer < DEPTH - 1) {
          uint2 ob;
          ob.x = pack2(o.x, o.y); ob.y = pack2(o.z, o.w);
          *reinterpret_cast<uint2*>(p.xb + (size_t)row * DM + c) = ob;
        }
      }
    }
  }
}

__device__ __forceinline__ void qk_tile(const u16* sK, const bf16x8 (&qf)[4], f32x16 (&st)[2], int lane) {
  const int r = lane & 31, hs = lane >> 5;
#pragma unroll
  for (int kb = 0; kb < 2; ++kb) {
    f32x16 c;
#pragma unroll
    for (int i = 0; i < 16; ++i) c[i] = 0.f;
#pragma unroll
    for (int ks = 0; ks < 4; ++ks) {
      bf16x8 a = ld_frag(sK + (kb * 32 + r) * LDT + ks * 16 + hs * 8);
      c = mfma32(a, qf[ks], c);
    }
    st[kb] = c;
  }
}
__device__ __forceinline__ void pv_tile(const u16* sV, const f32x16 (&pr)[2], f32x16 (&o)[2], int lane) {
  const int hs = lane >> 5, q = (lane & 15) >> 2, pp = lane & 3, cgp = (lane >> 4) & 1;
  bf16x8 pf[2][2];
#pragma unroll
  for (int kb = 0; kb < 2; ++kb)
#pragma unroll
    for (int s = 0; s < 2; ++s) {
      uint4 u;
      u.x = pack2(pr[kb][8 * s + 0], pr[kb][8 * s + 1]);
      u.y = pack2(pr[kb][8 * s + 2], pr[kb][8 * s + 3]);
      u.z = pack2(pr[kb][8 * s + 4], pr[kb][8 * s + 5]);
      u.w = pack2(pr[kb][8 * s + 6], pr[kb][8 * s + 7]);
      pf[kb][s] = __builtin_bit_cast(bf16x8, u);
    }
#pragma unroll
  for (int db = 0; db < 2; ++db)
#pragma unroll
    for (int kb = 0; kb < 2; ++kb)
#pragma unroll
      for (int s = 0; s < 2; ++s) {
        const int r0 = kb * 32 + 16 * s + 4 * hs;
        const u16* a0 = sV + (r0 + q) * LDT + db * 32 + cgp * 16 + pp * 4;
        bf16x8 a = tr_frag(a0, a0 + 8 * LDT);
        o[db] = mfma32(a, pf[kb][s], o[db]);
      }
}
__device__ __forceinline__ void load_tile64(u16* sT, const u16* __restrict__ src, size_t rs, int nvalid) {
#pragma unroll
  for (int i = 0; i < 2; ++i) {
    int id = tidx() + 256 * i;
    int row = id >> 3, ch = id & 7;
    uint4 v = make_uint4(0, 0, 0, 0);
    if (row < nvalid) v = *reinterpret_cast<const uint4*>(src + (size_t)row * rs + ch * 8);
    *reinterpret_cast<uint4*>(sT + row * LDT + ch * 8) = v;
  }
}

template <bool GUARD = true>
__device__ __forceinline__ void tile_ld(u32x4 (&r)[2], const u16* __restrict__ src, size_t rs, int nvalid, int tid) {
#pragma unroll
  for (int i = 0; i < 2; ++i) {
    const int id = tid + 256 * i;
    const int row = id >> 3, ch = id & 7;
    if (GUARD) {
      u32x4 v = {0u, 0u, 0u, 0u};
      if (row < nvalid) v = *reinterpret_cast<const u32x4*>(src + (size_t)row * rs + ch * 8);
      r[i] = v;
    } else {
      r[i] = *reinterpret_cast<const u32x4*>(src + (size_t)row * rs + ch * 8);
    }
  }
}
__device__ __forceinline__ void tile_st(u16* sT, const u32x4 (&r)[2], int tid) {
#pragma unroll
  for (int i = 0; i < 2; ++i) {
    const int id = tid + 256 * i;
    *reinterpret_cast<u32x4*>(sT + (id >> 3) * LDT + (id & 7) * 8) = r[i];
  }
}
__device__ __forceinline__ void add_bias(f32x16 (&st)[2], float sl, float b0) {
#pragma unroll
  for (int kb = 0; kb < 2; ++kb) {
    const float base = fmaf(sl, 32.f * (float)kb, b0);
#pragma unroll
    for (int r = 0; r < 16; ++r) {
      const float off = (float)((r & 3) + 8 * (r >> 2));
      st[kb][r] = fmaf(st[kb][r], C1, fmaf(sl, off, base));
    }
  }
}
__device__ __forceinline__ float softmax_step(f32x16 (&st)[2], float& mref, float& l) {
  float mx = NEGB;
#pragma unroll
  for (int kb = 0; kb < 2; ++kb)
#pragma unroll
    for (int r = 0; r < 16; ++r) mx = fmaxf(mx, st[kb][r]);
  float scale = 1.f;
  if (__any(mx > 64.f)) {
    mx = fmaxf(mx, __shfl_xor(mx, 32));
    const float d = fmaxf(mx, 0.f);
    scale = ex2(-d);
    mref += d;
    l *= scale;
#pragma unroll
    for (int kb = 0; kb < 2; ++kb)
#pragma unroll
      for (int r = 0; r < 16; ++r) st[kb][r] -= d;
  }
  float ps = 0.f;
#pragma unroll
  for (int kb = 0; kb < 2; ++kb)
#pragma unroll
    for (int r = 0; r < 16; ++r) {
      const float pv = ex2(st[kb][r]);
      st[kb][r] = pv;
      ps += pv;
    }
  l += ps;
  return scale;
}
__device__ __forceinline__ float dpp_xor1(float v) {
  return __builtin_bit_cast(float, __builtin_amdgcn_update_dpp(0, __builtin_bit_cast(int, v), 0xB1, 0xF, 0xF, true));
}
__device__ __forceinline__ float dpp_xor2(float v) {
  return __builtin_bit_cast(float, __builtin_amdgcn_update_dpp(0, __builtin_bit_cast(int, v), 0x4E, 0xF, 0xF, true));
}

__device__ __forceinline__ void compress_item(const Params& p, int layer, int kvsel, int tile, char* smem) {
  u16* sA = reinterpret_cast<u16*>(smem);
  u16* sW = sA + 32 * LDT;
  const int tid = tidx(), lane = tid & 63, w = tid >> 6;
  const u16* W1 = p.w1t + (size_t)(layer * 2 + kvsel) * 256 * 2048;
  const u16* W2 = p.w2t + (size_t)(layer * 2 + kvsel) * 64 * 256;
  const float* pos = p.cmp_pos + (size_t)(layer * 2 + kvsel) * 32 * 64;
  const int colbase = kvsel ? C_BCV : C_BCK;
  f32x4 acc[2][4];
#pragma unroll
  for (int m = 0; m < 2; ++m)
#pragma unroll
    for (int n = 0; n < 4; ++n) acc[m][n] = (f32x4){0.f, 0.f, 0.f, 0.f};
  const int ar = tid >> 3, ach = tid & 7;
  const int R = tile * 32 + ar;
  const int bk = R >> 9;
  int nn = R & 511;
  if (nn > 510) nn = 510;
  const u16* arow = p.h + ((size_t)((bk >> 1) * SEQ + 16 * nn)) * HC + colbase + (bk & 1) * 64 + ach * 8;
  const int wrow = tid >> 3, wch = (tid & 7) * 8;
  u32x4 w0[8], w1[8], h0, h1;
  f32x4 q0[2], q1[2];
  auto ldstage = [&](u32x4 (&wr)[8], u32x4& hr, f32x4 (&pr)[2], int i) {
    const int ic = i < 32 ? i : 31;
    hr = *reinterpret_cast<const u32x4*>(arow + (size_t)ic * HC);
    const f32x4* pp = reinterpret_cast<const f32x4*>(pos + ic * 64 + ach * 8);
    pr[0] = pp[0];
    pr[1] = pp[1];
#pragma unroll
    for (int j = 0; j < 8; ++j) wr[j] = *reinterpret_cast<const u32x4*>(W1 + (size_t)(wrow + 32 * j) * 2048 + ic * 64 + wch);
  };
  auto ststage = [&](const u32x4 (&wr)[8], const u32x4& hr, const f32x4 (&pr)[2]) {
    u32x4 o;
    o.x = pack2(lo_f(hr.x) + pr[0].x, hi_f(hr.x) + pr[0].y);
    o.y = pack2(lo_f(hr.y) + pr[0].z, hi_f(hr.y) + pr[0].w);
    o.z = pack2(lo_f(hr.z) + pr[1].x, hi_f(hr.z) + pr[1].y);
    o.w = pack2(lo_f(hr.w) + pr[1].z, hi_f(hr.w) + pr[1].w);
    *reinterpret_cast<u32x4*>(sA + ar * LDT + ach * 8) = o;
#pragma unroll
    for (int j = 0; j < 8; ++j) *reinterpret_cast<u32x4*>(sW + (wrow + 32 * j) * LDT + wch) = wr[j];
  };
  auto compute = [&]() {
#pragma unroll
    for (int kk = 0; kk < 2; ++kk) {
      bf16x8 a[2], b[4];
#pragma unroll
      for (int m = 0; m < 2; ++m) a[m] = ld_frag(sA + (m * 16 + (lane & 15)) * LDT + kk * 32 + (lane >> 4) * 8);
#pragma unroll
      for (int n = 0; n < 4; ++n) b[n] = ld_frag(sW + (w * 64 + n * 16 + (lane & 15)) * LDT + kk * 32 + (lane >> 4) * 8);
#pragma unroll
      for (int m = 0; m < 2; ++m)
#pragma unroll
        for (int n = 0; n < 4; ++n) acc[m][n] = mfma16(a[m], b[n], acc[m][n]);
    }
  };
  ldstage(w0, h0, q0, 0);
  asm volatile("" ::: "memory");
  ldstage(w1, h1, q1, 1);
  for (int i = 0; i < 32; i += 2) {
    ststage(w0, h0, q0);
    __syncthreads();
    ldstage(w0, h0, q0, i + 2);
    compute();
    __syncthreads();
    ststage(w1, h1, q1);
    __syncthreads();
    ldstage(w1, h1, q1, i + 3);
    compute();
    __syncthreads();
  }
  u16* sH = reinterpret_cast<u16*>(smem);
  u16* sW2 = sH + 32 * 264;
#pragma unroll
  for (int m = 0; m < 2; ++m)
#pragma unroll
    for (int n = 0; n < 4; ++n)
#pragma unroll
      for (int e = 0; e < 4; ++e) {
        int row = m * 16 + (lane >> 4) * 4 + e, col = w * 64 + n * 16 + (lane & 15);
        sH[row * 264 + col] = f2bf(gelu_tanh(acc[m][n][e]));
      }
#pragma unroll
  for (int j = 0; j < 8; ++j) {
    int id = tid + 256 * j;
    int row = id >> 5, ch = id & 31;
    uint4 v = *reinterpret_cast<const uint4*>(W2 + (size_t)row * 256 + ch * 8);
    *reinterpret_cast<uint4*>(sW2 + row * 264 + ch * 8) = v;
  }
  __syncthreads();
  f32x4 a2[2];
  a2[0] = (f32x4){0.f, 0.f, 0.f, 0.f};
  a2[1] = (f32x4){0.f, 0.f, 0.f, 0.f};
#pragma unroll
  for (int kk = 0; kk < 8; ++kk) {
    bf16x8 b = ld_frag(sW2 + (w * 16 + (lane & 15)) * 264 + kk * 32 + (lane >> 4) * 8);
#pragma unroll
    for (int m = 0; m < 2; ++m) {
      bf16x8 a = ld_frag(sH + (m * 16 + (lane & 15)) * 264 + kk * 32 + (lane >> 4) * 8);
      a2[m] = mfma16(a, b, a2[m]);
    }
  }
  u16* dst = kvsel ? p.vcmp : p.kcmp;
#pragma unroll
  for (int m = 0; m < 2; ++m)
#pragma unroll
    for (int e = 0; e < 4; ++e) {
      int row = m * 16 + (lane >> 4) * 4 + e, d = w * 16 + (lane & 15);
      int RR = tile * 32 + row;
      if ((RR & 511) < 511) dst[(size_t)RR * 64 + d] = f2bf(a2[m][e]);
    }
  __syncthreads();
}

struct BP {
  const u16 *Q, *K, *V, *gate;
  u16* O;
  float* LSE;
  size_t rs, os, ls;
  int qblk, window, mode, kstart, ntiles, has_sink;
  float slope_l2, sink_l2;
};
__device__ __forceinline__ void banded_decode(const Params& p, int layer, int i, BP& d) {
  d.gate = nullptr; d.LSE = nullptr; d.rs = HC; d.os = 512; d.ls = 0; d.mode = 0; d.sink_l2 = 0.f; d.has_sink = 0;
  float slope;
  if (i < 1024) {
    const int b = i >> 9, hh = (i >> 6) & 7;
    d.qblk = i & 63;
    const u16* base = p.h + (size_t)b * SEQ * HC;
    d.Q = base + C_BQ + hh * 64; d.K = base + C_BWK + (hh >> 2) * 64; d.V = base + C_BWV + (hh >> 2) * 64;
    d.window = 511;
    slope = exp2f(-(float)(hh + 1));
    d.O = p.owin + (size_t)b * SEQ * 512 + hh * 64;
  } else if (i < 4096) {
    i -= 1024;
    const int g = i >> 10, r = i & 1023;
    const int b = r >> 9, hh = (r >> 6) & 7, cb = r & 63;
    const int dil = g == 0 ? 1 : (g == 1 ? 4 : 16);
    const int bpc = 64 / dil;
    const int c = cb / bpc;
    d.qblk = cb % bpc;
    const u16* base = p.h + ((size_t)b * SEQ + c) * HC;
    d.Q = base + C_AQ + g * 512 + hh * 64; d.K = base + C_AK + g * 512 + hh * 64; d.V = base + C_AV + g * 512 + hh * 64;
    d.rs = (size_t)dil * HC;
    d.window = 128;
    slope = exp2f(-8.f * (float)(g * 8 + hh + 1) / 24.f) * (float)dil;
    d.O = p.oA + ((size_t)g * NTOK + (size_t)b * SEQ + c) * 512 + hh * 64;
    d.os = (size_t)dil * 512;
    d.LSE = p.lseA + ((size_t)g * NTOK + (size_t)b * SEQ + c) * 8 + hh;
    d.ls = (size_t)dil * 8;
  } else {
    i -= 4096;
    const int b = i >> 9, hh = (i >> 6) & 7;
    d.qblk = i & 63;
    const u16* base = p.h + (size_t)b * SEQ * HC;
    d.Q = base + C_CQ + hh * 64; d.K = base + C_CK + (hh >> 2) * 64; d.V = base + C_CV + (hh >> 2) * 64;
    d.window = 127;
    slope = exp2f(-(float)(hh + 1));
    d.has_sink = 1;
    d.sink_l2 = p.sinks[layer * 8 + hh] * LOG2E;
    d.mode = 1;
    d.O = p.y + ((size_t)2 * NTOK + (size_t)b * SEQ) * 512 + hh * 64;
    d.gate = base + C_CG + hh * 64;
  }
  d.slope_l2 = slope * LOG2E;
  const int nb = (d.window + 127) >> 7;
  int ks = d.qblk * 128 - nb * 128;
  if (ks < 0) ks = 0;
  d.kstart = ks;
  d.ntiles = (d.qblk * 128 + 128 - ks) >> 6;
}

__device__ __forceinline__ void phase_attn1(const Params& p, int layer, char* smem) {
  int* slot = reinterpret_cast<int*>(smem + SMEM_BYTES);
  unsigned* ctrA = p.ctr + layer * 4;
  unsigned* ctrB = ctrA + 1;
  for (;;) {
    const int i = next_item(ctrA, slot);
    if (i >= 256) break;
    if (i < 128) compress_item(p, layer, i >> 6, i & 63, smem);
    else gemm_in_tail_item(p, layer, i - 128, smem);
  }
  const int NBI = 5120;
  u16* sbase = reinterpret_cast<u16*>(smem);
  int gt = 0;
  const int tid = tidx(), lane = tid & 63, w = tid >> 6, hs = lane >> 5;
  int cur = next_item(ctrB, slot);
  int nxt = NBI;
  if (cur < NBI) nxt = next_item(ctrB, slot);
  BP bp;
  u32x4 ka[2], va[2], kb2[2], vb2[2];
  bf16x8 qf[4], qfn[4];
  f32x16 o[2];
  float m = 0.f, l = 0.f;
  int ti = 0;
  if (cur < NBI) {
    banded_decode(p, layer, cur, bp);
    tile_ld<false>(ka, bp.K + (size_t)bp.kstart * bp.rs, bp.rs, 64, tid);
    tile_ld<false>(va, bp.V + (size_t)bp.kstart * bp.rs, bp.rs, 64, tid);
    const int qp0 = bp.qblk * 128 + w * 32 + (lane & 31);
#pragma unroll
    for (int ks = 0; ks < 4; ++ks) qfn[ks] = ld_frag(bp.Q + (size_t)qp0 * bp.rs + ks * 16 + hs * 8);
    asm volatile("" ::: "memory");
    tile_ld<false>(kb2, bp.K + (size_t)(bp.kstart + 64) * bp.rs, bp.rs, 64, tid);
    tile_ld<false>(vb2, bp.V + (size_t)(bp.kstart + 64) * bp.rs, bp.rs, 64, tid);
  }
  auto step = [&](u32x4 (&kr)[2], u32x4 (&vr)[2]) {
    const int qw0 = bp.qblk * 128 + w * 32;
    const int qpos = qw0 + (lane & 31);
    if (ti == 0) {
#pragma unroll
      for (int ks = 0; ks < 4; ++ks) qf[ks] = qfn[ks];
#pragma unroll
      for (int i = 0; i < 16; ++i) { o[0][i] = 0.f; o[1][i] = 0.f; }
      m = 0.f; l = 0.f;
    }
    u16* sK = sbase + (gt & 1) * (128 * LDT);
    u16* sV = sK + 64 * LDT;
    tile_st(sK, kr, tid);
    tile_st(sV, vr, tid);
    __syncthreads();
    if (ti == 0 && tid == 0) *slot = (int)atomicAdd(ctrB, 1u);
    const int kt0 = bp.kstart + ti * 64;
    {
      const int t2 = ti + 2;
      if (t2 < bp.ntiles) {
        tile_ld<false>(kr, bp.K + (size_t)(bp.kstart + t2 * 64) * bp.rs, bp.rs, 64, tid);
        tile_ld<false>(vr, bp.V + (size_t)(bp.kstart + t2 * 64) * bp.rs, bp.rs, 64, tid);
      } else if (nxt < NBI) {
        BP bn;
        banded_decode(p, layer, nxt, bn);
        const int tn = t2 - bp.ntiles;
        tile_ld<false>(kr, bn.K + (size_t)(bn.kstart + tn * 64) * bn.rs, bn.rs, 64, tid);
        tile_ld<false>(vr, bn.V + (size_t)(bn.kstart + tn * 64) * bn.rs, bn.rs, 64, tid);
        if (tn == 0) {
          const int qpn = bn.qblk * 128 + w * 32 + (lane & 31);
#pragma unroll
          for (int ks = 0; ks < 4; ++ks) qfn[ks] = ld_frag(bn.Q + (size_t)qpn * bn.rs + ks * 16 + hs * 8);
        }
      }
    }
    if (kt0 <= qw0 + 31 && kt0 + 63 >= qw0 - bp.window) {
      f32x16 st[2];
      qk_tile(sK, qf, st, lane);
      add_bias(st, bp.slope_l2, bp.slope_l2 * (float)(kt0 + 4 * hs - qpos) - m);
      {
        const int d0 = qpos - kt0 - 4 * hs;
        if (kt0 + 63 > qw0) {
#pragma unroll
          for (int kb = 0; kb < 2; ++kb)
#pragma unroll
            for (int r = 0; r < 16; ++r)
              st[kb][r] = (kb * 32 + (r & 3) + 8 * (r >> 2) <= d0) ? st[kb][r] : NEGB;
        }
        if (kt0 < qw0 + 31 - bp.window) {
          const int dlo = d0 - bp.window;
#pragma unroll
          for (int kb = 0; kb < 2; ++kb)
#pragma unroll
            for (int r = 0; r < 16; ++r)
              st[kb][r] = (kb * 32 + (r & 3) + 8 * (r >> 2) >= dlo) ? st[kb][r] : NEGB;
        }
      }
      const float alpha = softmax_step(st, m, l);
      if (__any(alpha != 1.f)) {
#pragma unroll
        for (int i = 0; i < 16; ++i) { o[0][i] *= alpha; o[1][i] *= alpha; }
      }
      pv_tile(sV, st, o, lane);
    }
    ++gt;
    if (ti + 1 < bp.ntiles) {
      ++ti;
    } else {
      float lt = l + __shfl_xor(l, 32);
      if (bp.has_sink) lt += ex2(bp.sink_l2 - m);
      const float inv = 1.f / lt;
      if (bp.LSE != nullptr && hs == 0) bp.LSE[(size_t)qpos * bp.ls] = m + __log2f(lt);
      u16* sO = sbase + 2 * (128 * LDT) + w * (32 * LDT);
#pragma unroll
      for (int db = 0; db < 2; ++db)
#pragma unroll
        for (int q4 = 0; q4 < 4; ++q4) {
          const int d0 = db * 32 + 8 * q4 + 4 * hs;
          float v0 = o[db][4 * q4 + 0] * inv, v1 = o[db][4 * q4 + 1] * inv, v2 = o[db][4 * q4 + 2] * inv,
                v3 = o[db][4 * q4 + 3] * inv;
          if (bp.mode == 1) {
            uint2 gv = *reinterpret_cast<const uint2*>(bp.gate + (size_t)qpos * bp.rs + d0);
            v0 *= siluf_(lo_f(gv.x)); v1 *= siluf_(hi_f(gv.x)); v2 *= siluf_(lo_f(gv.y)); v3 *= siluf_(hi_f(gv.y));
          }
          uint2 ov;
          ov.x = pack2(v0, v1); ov.y = pack2(v2, v3);
          *reinterpret_cast<uint2*>(sO + (lane & 31) * LDT + d0) = ov;
        }
      asm volatile("s_waitcnt lgkmcnt(0)" ::: "memory");
#pragma unroll
      for (int i = 0; i < 4; ++i) {
        const int row = (lane >> 3) + 8 * i, ch = lane & 7;
        const u32x4 v = *reinterpret_cast<const u32x4*>(sO + row * LDT + ch * 8);
        *reinterpret_cast<u32x4*>(bp.O + (size_t)(qw0 + row) * bp.os + ch * 8) = v;
      }
      const int nn = *slot;
      cur = nxt;
      nxt = nn;
      ti = 0;
      if (cur < NBI) banded_decode(p, layer, cur, bp);
    }
  };
  while (cur < NBI) {
    step(ka, va);
    if (cur >= NBI) break;
    step(kb2, vb2);
  }
  __syncthreads();
}

__device__ __forceinline__ void nsa_item(const Params& p, int b, int kv, int chunk, char* smem) {
  u16* sbase = reinterpret_cast<u16*>(smem);
  int gt = 0;
  float* impAll = reinterpret_cast<float*>(smem + 36864);
  u64* selmask = reinterpret_cast<u64*>(smem + 36864 + 16896);
  u64* unionm = selmask + 64;
  const int tid = tidx(), lane = tid & 63, w = tid >> 6;
  const int hs = lane >> 5, n = lane & 31, g = n & 3, qi = n >> 2;
  const int head = kv * 4 + g;
  const int t0 = chunk * 32;
  const int t = t0 + 8 * w + qi;
  const int cur = t0 >> 6;
  const float slope_l2 = exp2f(-(float)(head + 1)) * LOG2E;
  float* impw = impAll + w * 8 * IMPS;
  unsigned* keyw = reinterpret_cast<unsigned*>(impw);
  const u16* hrow = p.h + ((size_t)b * SEQ + t) * HC;
  bf16x8 qf[4];
#pragma unroll
  for (int ks = 0; ks < 4; ++ks) qf[ks] = ld_frag(hrow + C_BQ + head * 64 + ks * 16 + hs * 8);
  for (int i = lane; i < 8 * IMPS; i += 64) impw[i] = 0.f;

  const u16* kc = p.kcmp + (size_t)(b * 2 + kv) * 512 * 64;
  const u16* vc = p.vcmp + (size_t)(b * 2 + kv) * 512 * 64;
  const int ncmp = 2 * chunk + 1;
  const int ntile = (ncmp + 63) >> 6;
  const int jmax = (t - 31) >> 4;
  const int jmax_w = (t0 + 8 * w - 31) >> 4;
  const float sl16 = 16.f * slope_l2;
  const float cb = slope_l2 * (float)(31 - t);
  u32x4 kr[2], vr[2];
  float m = 0.f, l = 0.f;
  tile_ld(kr, kc, 64, 511, tid);
  for (int tl = 0; tl < ntile; ++tl, ++gt) {
    const int j0 = tl * 64;
    u16* sK = sbase + (gt & 1) * (128 * LDT);
    tile_st(sK, kr, tid);
    __syncthreads();
    if (tl + 1 < ntile) tile_ld(kr, kc + (size_t)(j0 + 64) * 64, 64, 511 - (j0 + 64), tid);
    else { tile_ld(kr, kc, 64, 511, tid); tile_ld(vr, vc, 64, 511, tid); }
    {
      f32x16 st[2];
      qk_tile(sK, qf, st, lane);
      add_bias(st, sl16, fmaf(sl16, (float)(j0 + 4 * hs), cb) - m);
      if (j0 + 63 > jmax_w) {
        const int lim = jmax - j0 - 4 * hs;
#pragma unroll
        for (int kb = 0; kb < 2; ++kb)
#pragma unroll
          for (int r = 0; r < 16; ++r)
            st[kb][r] = (kb * 32 + (r & 3) + 8 * (r >> 2) <= lim) ? st[kb][r] : NEGB;
      }
      (void)softmax_step(st, m, l);
    }
  }
  l += __shfl_xor(l, 32);
  const float invl = l > 0.f ? 1.f / l : 1.f;
  const float mref = m;
  f32x16 ocmp[2];
#pragma unroll
  for (int i = 0; i < 16; ++i) { ocmp[0][i] = 0.f; ocmp[1][i] = 0.f; }
  for (int tl = 0; tl < ntile; ++tl, ++gt) {
    const int j0 = tl * 64;
    u16* sK = sbase + (gt & 1) * (128 * LDT);
    u16* sV = sK + 64 * LDT;
    tile_st(sK, kr, tid);
    tile_st(sV, vr, tid);
    __syncthreads();
    if (tl + 1 < ntile) {
      tile_ld(kr, kc + (size_t)(j0 + 64) * 64, 64, 511 - (j0 + 64), tid);
      tile_ld(vr, vc + (size_t)(j0 + 64) * 64, 64, 511 - (j0 + 64), tid);
    } else {
      tile_ld<false>(kr, p.h + (size_t)b * SEQ * HC + C_BSK + kv * 64, HC, 64, tid);
      tile_ld<false>(vr, p.h + (size_t)b * SEQ * HC + C_BSV + kv * 64, HC, 64, tid);
    }
    {
      f32x16 st[2];
      qk_tile(sK, qf, st, lane);
      add_bias(st, sl16, fmaf(sl16, (float)(j0 + 4 * hs), cb) - mref);
      if (j0 + 63 > jmax_w) {
        const int lim = jmax - j0 - 4 * hs;
#pragma unroll
        for (int kb = 0; kb < 2; ++kb)
#pragma unroll
          for (int r = 0; r < 16; ++r)
            st[kb][r] = (kb * 32 + (r & 3) + 8 * (r >> 2) <= lim) ? st[kb][r] : NEGB;
      }
#pragma unroll
      for (int kb = 0; kb < 2; ++kb)
#pragma unroll
        for (int r = 0; r < 16; ++r) st[kb][r] = ex2(st[kb][r]) * invl;
#pragma unroll
      for (int kb = 0; kb < 2; ++kb)
#pragma unroll
        for (int q4 = 0; q4 < 4; ++q4) {
          float last = st[kb][4 * q4 + 3];
          float sum4 = st[kb][4 * q4] + st[kb][4 * q4 + 1] + st[kb][4 * q4 + 2] + last;
          sum4 += dpp_xor1(sum4);
          sum4 += dpp_xor2(sum4);
          last += dpp_xor1(last);
          last += dpp_xor2(last);
          const int sidx = (j0 + kb * 32 + 8 * q4 + 4 * hs) >> 2;
          if (g == 0) impw[qi * IMPS + sidx] += sum4;
          if (g == 0 && sidx + 1 < 128) impw[qi * IMPS + sidx + 1] += last;
        }
      pv_tile(sV, st, ocmp, lane);
    }
  }
  for (int q = 0; q < 8; ++q) {
#pragma unroll
    for (int hh = 0; hh < 2; ++hh) {
      const int s = lane + 64 * hh;
      float v = impw[q * IMPS + s];
      const bool forced = (s == 0) || (s == cur) || (s == cur - 1);
      v = forced ? 1e4f : v;
      unsigned key = (__float_as_uint(v) & 0xffffff80u) | (unsigned)(127 - s);
      if (s > cur) key = 0u;
      keyw[q * IMPS + s] = key;
    }
  }
  u64 ulo = 0, uhi = 0;
  const int n4 = (cur >> 2) + 1;
  for (int q = 0; q < 8; ++q) {
    const unsigned k0 = keyw[q * IMPS + lane], k1 = keyw[q * IMPS + lane + 64];
    int r0 = 0, r1 = 0;
    const uint4* kp = reinterpret_cast<const uint4*>(keyw + q * IMPS);
#pragma unroll 4
    for (int s4 = 0; s4 < n4; ++s4) {
      uint4 x = kp[s4];
      r0 += (x.x > k0) + (x.y > k0) + (x.z > k0) + (x.w > k0);
      r1 += (x.x > k1) + (x.y > k1) + (x.z > k1) + (x.w > k1);
    }
    const bool s0 = (lane <= cur) && (r0 < 16);
    const bool s1 = (lane + 64 <= cur) && (r1 < 16);
    const u64 mlo = __ballot(s0), mhi = __ballot(s1);
    if (lane == 0) { selmask[(w * 8 + q) * 2] = mlo; selmask[(w * 8 + q) * 2 + 1] = mhi; }
    ulo |= mlo; uhi |= mhi;
  }
  if (lane == 0) { unionm[w * 2] = ulo; unionm[w * 2 + 1] = uhi; }
  __syncthreads();
  const u64 mylo = selmask[(w * 8 + qi) * 2], myhi = selmask[(w * 8 + qi) * 2 + 1];
  u64 blo = unionm[0] | unionm[2] | unionm[4] | unionm[6];
  u64 bhi = unionm[1] | unionm[3] | unionm[5] | unionm[7];
  f32x16 osel[2];
#pragma unroll
  for (int i = 0; i < 16; ++i) { osel[0][i] = 0.f; osel[1][i] = 0.f; }
  float m2 = 0.f, l2 = 0.f;
  const u16* ksel = p.h + (size_t)b * SEQ * HC + C_BSK + kv * 64;
  const u16* vsel = p.h + (size_t)b * SEQ * HC + C_BSV + kv * 64;
  int j = 0;
  blo &= blo - 1;
  for (; j >= 0; ++gt) {
    u16* sK = sbase + (gt & 1) * (128 * LDT);
    u16* sV = sK + 64 * LDT;
    tile_st(sK, kr, tid);
    tile_st(sV, vr, tid);
    __syncthreads();
    int jn = -1;
    if (blo) { jn = __builtin_ctzll(blo); blo &= blo - 1; }
    else if (bhi) { jn = 64 + __builtin_ctzll(bhi); bhi &= bhi - 1; }
    if (jn >= 0) {
      tile_ld<false>(kr, ksel + (size_t)jn * 64 * HC, HC, 64, tid);
      tile_ld<false>(vr, vsel + (size_t)jn * 64 * HC, HC, 64, tid);
    }
    const u64 wsel = j < 64 ? (ulo >> j) : (uhi >> (j - 64));
    if (wsel & 1ull) {
      const u64 msel = j < 64 ? (mylo >> j) : (myhi >> (j - 64));
      const bool mine = (msel & 1ull) != 0;
      f32x16 st[2];
      qk_tile(sK, qf, st, lane);
      add_bias(st, slope_l2, mine ? slope_l2 * (float)(j * 64 + 4 * hs - t) - m2 : NEGB);
      if (j >= cur) {
        const int d0 = t - j * 64 - 4 * hs;
#pragma unroll
        for (int kb = 0; kb < 2; ++kb)
#pragma unroll
          for (int r = 0; r < 16; ++r)
            st[kb][r] = (kb * 32 + (r & 3) + 8 * (r >> 2) <= d0) ? st[kb][r] : NEGB;
      }
      const float alpha = softmax_step(st, m2, l2);
      if (__any(alpha != 1.f)) {
#pragma unroll
        for (int i = 0; i < 16; ++i) { osel[0][i] *= alpha; osel[1][i] *= alpha; }
      }
      pv_tile(sV, st, osel, lane);
    }
    j = jn;
  }
  l2 += __shfl_xor(l2, 32);
  const float inv2 = 1.f / l2;
  const float g0 = sigmoidf_(bf2f(hrow[C_BGATE + head * 3 + 0]));
  const float g1 = sigmoidf_(bf2f(hrow[C_BGATE + head * 3 + 1])) * inv2;
  const float g2 = sigmoidf_(bf2f(hrow[C_BGATE + head * 3 + 2]));
  const u16* ow = p.owin + ((size_t)b * SEQ + t) * 512 + head * 64;
  u16* sO = reinterpret_cast<u16*>(smem + 55296) + w * (32 * LDT);
#pragma unroll
  for (int db = 0; db < 2; ++db)
#pragma unroll
    for (int q4 = 0; q4 < 4; ++q4) {
      const int d0 = db * 32 + 8 * q4 + 4 * hs;
      uint2 wv = *reinterpret_cast<const uint2*>(ow + d0);
      uint2 gv = *reinterpret_cast<const uint2*>(hrow + C_BG + head * 64 + d0);
      float v0 = (g0 * ocmp[db][4 * q4 + 0] + g1 * osel[db][4 * q4 + 0] + g2 * lo_f(wv.x)) * siluf_(lo_f(gv.x));
      float v1 = (g0 * ocmp[db][4 * q4 + 1] + g1 * osel[db][4 * q4 + 1] + g2 * hi_f(wv.x)) * siluf_(hi_f(gv.x));
      float v2 = (g0 * ocmp[db][4 * q4 + 2] + g1 * osel[db][4 * q4 + 2] + g2 * lo_f(wv.y)) * siluf_(lo_f(gv.y));
      float v3 = (g0 * ocmp[db][4 * q4 + 3] + g1 * osel[db][4 * q4 + 3] + g2 * hi_f(wv.y)) * siluf_(hi_f(gv.y));
      uint2 ov;
      ov.x = pack2(v0, v1); ov.y = pack2(v2, v3);
      *reinterpret_cast<uint2*>(sO + n * LDT + d0) = ov;
    }
  asm volatile("s_waitcnt lgkmcnt(0)" ::: "memory");
#pragma unroll
  for (int i = 0; i < 4; ++i) {
    const int row = (lane >> 3) + 8 * i, ch = lane & 7;
    const u32x4 v = *reinterpret_cast<const u32x4*>(sO + row * LDT + ch * 8);
    *reinterpret_cast<u32x4*>(p.y + ((size_t)NTOK + (size_t)b * SEQ + t0 + 8 * w + (row >> 2)) * 512 +
                              (kv * 4 + (row & 3)) * 64 + ch * 8) = v;
  }
  __syncthreads();
}

__device__ __forceinline__ void combineA_item(const Params& p, int item) {
#pragma unroll 4
  for (int j = 0; j < 8; ++j) {
    const int id = tidx() + 256 * j;
    const int tt = item * 32 + (id >> 6), c0 = (id & 63) * 8, hh = c0 >> 6;
    float l0 = p.lseA[((size_t)0 * NTOK + tt) * 8 + hh];
    float l1 = p.lseA[((size_t)1 * NTOK + tt) * 8 + hh];
    float l2 = p.lseA[((size_t)2 * NTOK + tt) * 8 + hh];
    const float mx = fmaxf(l0, fmaxf(l1, l2));
    float w0 = ex2(l0 - mx), w1 = ex2(l1 - mx), w2 = ex2(l2 - mx);
    const float inv = 1.f / (w0 + w1 + w2);
    w0 *= inv; w1 *= inv; w2 *= inv;
    uint4 a0 = *reinterpret_cast<const uint4*>(p.oA + ((size_t)0 * NTOK + tt) * 512 + c0);
    uint4 a1 = *reinterpret_cast<const uint4*>(p.oA + ((size_t)1 * NTOK + tt) * 512 + c0);
    uint4 a2 = *reinterpret_cast<const uint4*>(p.oA + ((size_t)2 * NTOK + tt) * 512 + c0);
    uint4 gv = *reinterpret_cast<const uint4*>(p.h + (size_t)tt * HC + C_AG + c0);
    uint4 o;
    o.x = pack2((w0 * lo_f(a0.x) + w1 * lo_f(a1.x) + w2 * lo_f(a2.x)) * siluf_(lo_f(gv.x)),
                (w0 * hi_f(a0.x) + w1 * hi_f(a1.x) + w2 * hi_f(a2.x)) * siluf_(hi_f(gv.x)));
    o.y = pack2((w0 * lo_f(a0.y) + w1 * lo_f(a1.y) + w2 * lo_f(a2.y)) * siluf_(lo_f(gv.y)),
                (w0 * hi_f(a0.y) + w1 * hi_f(a1.y) + w2 * hi_f(a2.y)) * siluf_(hi_f(gv.y)));
    o.z = pack2((w0 * lo_f(a0.z) + w1 * lo_f(a1.z) + w2 * lo_f(a2.z)) * siluf_(lo_f(gv.z)),
                (w0 * hi_f(a0.z) + w1 * hi_f(a1.z) + w2 * hi_f(a2.z)) * siluf_(hi_f(gv.z)));
    o.w = pack2((w0 * lo_f(a0.w) + w1 * lo_f(a1.w) + w2 * lo_f(a2.w)) * siluf_(lo_f(gv.w)),
                (w0 * hi_f(a0.w) + w1 * hi_f(a1.w) + w2 * hi_f(a2.w)) * siluf_(hi_f(gv.w)));
    *reinterpret_cast<uint4*>(p.y + (size_t)tt * 512 + c0) = o;
  }
}

__device__ __forceinline__ void phase_attn2(const Params& p, int layer, char* smem) {
  const int total = 1024 + 512;
  int* slot = reinterpret_cast<int*>(smem + SMEM_BYTES);
  unsigned* ctr = p.ctr + layer * 4 + 2;
  for (;;) {
    const int idx = next_item(ctr, slot);
    if (idx >= total) break;
    if (idx < 1024) {
      const int chunk = 255 - (idx >> 2), b = (idx >> 1) & 1, kv = idx & 1;
      nsa_item(p, b, kv, chunk, smem);
    } else {
      combineA_item(p, idx - 1024);
    }
  }
}

#define XB_TMO 128
#define XB_XCNT(j) (256 + 64 * (j))
#define XB_XSUB(j) (1280 + 64 * (j))
#define XB_XGEN(j) (2304 + 64 * (j))
#define XB_TOP 3328
#define XB_TOPGEN 3392
#define XB_SPIN_CAP (1u << 20)
__device__ __forceinline__ unsigned xb_ld(unsigned* q) { return __hip_atomic_load(q, __ATOMIC_RELAXED, __HIP_MEMORY_SCOPE_AGENT); }
__device__ __forceinline__ unsigned xb_add(unsigned* q, unsigned v) {
  return __hip_atomic_fetch_add(q, v, __ATOMIC_RELAXED, __HIP_MEMORY_SCOPE_AGENT);
}
__device__ __forceinline__ unsigned xb_xcc_id() { return (unsigned)__builtin_amdgcn_s_getreg((3 << 11) | 20) & 0xFu; }
#define XB_SPIN(cond, bar)                                                                    \
  do {                                                                                        \
    unsigned _sp = 0;                                                                         \
    while (cond) {                                                                            \
      __builtin_amdgcn_s_sleep(1);                                                            \
      if ((++_sp & 255u) == 0u) {                                                             \
        if (xb_ld(&(bar)[XB_TMO])) break;                                                     \
        if (_sp > XB_SPIN_CAP) { atomicAdd(&(bar)[XB_TMO], 1u); break; }                      \
      }                                                                                       \
    }                                                                                         \
  } while (0)
__device__ __forceinline__ void xcd_barrier(unsigned* bar, volatile unsigned* xst) {
  asm volatile("s_waitcnt vmcnt(0)" ::: "memory");
  __syncthreads();
  if (threadIdx.x == 0) {
    __builtin_amdgcn_s_waitcnt(0);
    unsigned nloc = xst[0], nx = xst[1];
    const unsigned x = xst[2];
    if (nloc == 0u) {
      const unsigned G = gridDim.x;
      unsigned sp = 0u;
      for (;;) {
        unsigned sum = 0u, cnt = 0u, mine = 0u;
#pragma unroll
        for (unsigned j = 0; j < 16; ++j) {
          const unsigned c = xb_ld(&bar[XB_XCNT(j)]);
          sum += c;
          cnt += (c > 0u) ? 1u : 0u;
          mine = (j == x) ? c : mine;
        }
        nloc = mine > 0u ? mine : 1u;
        nx = cnt > 0u ? cnt : 1u;
        if (sum == G) break;
        __builtin_amdgcn_s_sleep(1);
        if ((++sp & 255u) == 0u) {
          if (xb_ld(&bar[XB_TMO])) break;
          if (sp > XB_SPIN_CAP) { atomicAdd(&bar[XB_TMO], 1u); break; }
        }
      }
      xst[0] = nloc;
      xst[1] = nx;
    }
    const unsigned old = xb_add(&bar[XB_XSUB(x)], 1u);
    const unsigned gen = old / nloc;
    if (old + 1u == (gen + 1u) * nloc) {
      __builtin_amdgcn_fence(__ATOMIC_RELEASE, "agent");
      asm volatile("s_waitcnt vmcnt(0)" ::: "memory");
      const unsigned og = xb_add(&bar[XB_TOP], 1u);
      const unsigned tg = og / nx;
      if (og + 1u == (tg + 1u) * nx) xb_add(&bar[XB_TOPGEN], 1u);
      else XB_SPIN(xb_ld(&bar[XB_TOPGEN]) == tg, bar);
      __builtin_amdgcn_fence(__ATOMIC_ACQUIRE, "agent");
      xb_add(&bar[XB_XGEN(x)], 1u);
      asm volatile("s_waitcnt vmcnt(0)" ::: "memory");
    } else {
      XB_SPIN(xb_ld(&bar[XB_XGEN(x)]) == gen, bar);
      __builtin_amdgcn_fence(__ATOMIC_ACQUIRE, "agent");
      asm volatile("s_waitcnt vmcnt(0)" ::: "memory");
    }
  }
  __syncthreads();
}

__global__ void __launch_bounds__(256, 2) mega(Params p, int ph_lo, int ph_hi) {
  __shared__ __attribute__((aligned(16))) char smem[SMEM_BYTES + 16];
  __shared__ unsigned xst[4];
  cg::grid_group grid = cg::this_grid();
  if (ph_hi < 0) grid.sync();
  if (threadIdx.x == 0) {
    const unsigned x = xb_xcc_id();
    xst[0] = 0u;
    xst[1] = 0u;
    xst[2] = x;
    (void)xb_add(&p.xbar[XB_XCNT(x)], 1u);
  }
  for (int ph = ph_lo; ph <= ph_hi; ++ph) {
    const bool ln_fused = (gridDim.x == 512) && ph > 0 && ((ph - 1) % 6 == 5);
    if (ln_fused) continue;
    if (ph > ph_lo) xcd_barrier(p.xbar, xst);
    if (ph == 0) {
      phase_prep(p, smem);
    } else {
      const int layer = (ph - 1) / 6, s = (ph - 1) % 6;
      switch (s) {
        case 0: phase_gemm_in(p, layer, smem); break;
        case 1: phase_attn1(p, layer, smem); break;
        case 2: phase_attn2(p, layer, smem); break;
        case 3: phase_gemm_branch(p, layer, smem); break;
        case 4: phase_gemm_out(p, layer, smem); break;
        default: phase_ln(p, layer); break;
      }
    }
  }
}

extern "C" void kernel_launch(void* const* d_in, const int* in_sizes, int n_in, void* d_out, int out_size, void* d_ws,
                              size_t ws_size, hipStream_t stream) {
  Params p{};
  p.x = (const float*)d_in[0];
  p.w_in = (const float*)d_in[1];
  p.b_in = (const float*)d_in[2];
  p.w_cmp1 = (const float*)d_in[3];
  p.w_cmp2 = (const float*)d_in[4];
  p.cmp_pos = (const float*)d_in[5];
  p.sinks = (const float*)d_in[6];
  p.w_branch = (const float*)d_in[7];
  p.w_out = (const float*)d_in[8];
  p.ln_g = (const float*)d_in[9];
  p.ln_b = (const float*)d_in[10];
  p.out = (float*)d_out;
  char* ws = (char*)d_ws;
  size_t off = 0;
  auto take = [&](size_t bytes) { char* r = ws + off; off += (bytes + 255) & ~(size_t)255; return r; };
  p.xb = (u16*)take((size_t)NTOK * DM * 2);
  p.wt_in = (u16*)take((size_t)DEPTH * HC * DM * 2);
  p.w1t = (u16*)take((size_t)DEPTH * 2 * 256 * 2048 * 2);
  p.w2t = (u16*)take((size_t)DEPTH * 2 * 64 * 256 * 2);
  p.wbt = (u16*)take((size_t)DEPTH * 3 * 1024 * 512 * 2);
  p.wot = (u16*)take((size_t)DEPTH * 1024 * 1024 * 2);
  p.bias = (float*)take((size_t)DEPTH * HC * 4);
  p.h = (u16*)take((size_t)NTOK * HC * 2);
  p.z = (float*)p.h;
  p.oA = (u16*)take((size_t)3 * NTOK * 512 * 2);
  p.merged = p.oA;
  p.lseA = (float*)take((size_t)3 * NTOK * 8 * 4);
  p.owin = (u16*)take((size_t)NTOK * 512 * 2);
  p.y = (u16*)take((size_t)3 * NTOK * 512 * 2);
  p.kcmp = (u16*)take((size_t)4 * 512 * 64 * 2);
  p.vcmp = (u16*)take((size_t)4 * 512 * 64 * 2);
  p.ctr = (unsigned*)take(8192);
  p.lnpart = (unsigned*)take((size_t)DEPTH * 128 * 4 * 128 * 2 * 4);
  p.xbar = (unsigned*)take(16384);

  static int grid_blocks = 0;
  if (!grid_blocks) {
    int dev = 0, cus = 0, per_cu = 0;
    hipGetDevice(&dev);
    hipDeviceGetAttribute(&cus, hipDeviceAttributeMultiprocessorCount, dev);
    hipOccupancyMaxActiveBlocksPerMultiprocessor(&per_cu, mega, 256, 0);
    if (per_cu < 1) per_cu = 1;
    if (per_cu > 2) per_cu = 2;
    grid_blocks = cus * per_cu;
  }
  hipMemsetAsync(p.xbar, 0, 16384, stream);
  int lo = 0, hi = 6 * DEPTH;
  void* args[] = {&p, &lo, &hi};
  hipError_t e = hipLaunchCooperativeKernel((void*)mega, dim3(grid_blocks), dim3(256), args, 0, stream);
  if (e != hipSuccess) fprintf(stderr, "cooperative launch failed: %s (grid %d)\n", hipGetErrorString(e), grid_blocks);
}
```
